# Optimizing an MI355X kernel written in HIP

```python
import math
import jax, jax.numpy as jnp
from jax import lax
import numpy as np

D_MODEL = 1024
BATCH = 8
SEQ = 4096
DEPTH = 1

HEAD_DIM = 64
CONV_WIDTH = D_MODEL // 2
CONV_GROUPS = CONV_WIDTH // HEAD_DIM
CONV_K = 3
LRU_WIDTH = D_MODEL
LRU_HEADS = LRU_WIDTH // HEAD_DIM
LRU_CONV_K = 4
LRU_C = 8.0
MIX_WIDTH = CONV_WIDTH + LRU_WIDTH
IN_COLS = 3 * CONV_WIDTH + 2 * LRU_WIDTH
D_FF = 4 * D_MODEL
EPS = 1e-6

kernel_name = "hymba_style_shortconv_rglru_block"


def rmsnorm(x, g):
    xf = x.astype(jnp.float32)
    y = xf * lax.rsqrt(jnp.mean(xf * xf, axis=-1, keepdims=True) + EPS)
    return (y * g.astype(jnp.float32)).astype(x.dtype)


def causal_dwconv(x, w):
    k_len = w.shape[0]
    s = x.shape[1]
    xp = jnp.pad(x, ((0, 0), (k_len - 1, 0), (0, 0)))
    y = w[0] * xp[:, 0:s]
    for k in range(1, k_len):
        y = y + w[k] * xp[:, k:k + s]
    return y


def block_diag_linear(x, w, b):
    bt, s, _ = x.shape
    xh = x.reshape(bt, s, LRU_HEADS, HEAD_DIM)
    y = jnp.einsum('bshi,hij->bshj', xh, w).reshape(bt, s, LRU_WIDTH)
    return y + b


def rg_lru(x, w_a, b_a, w_x, b_x, lam):
    r = jax.nn.sigmoid(block_diag_linear(x, w_a, b_a).astype(jnp.float32))
    i = jax.nn.sigmoid(block_diag_linear(x, w_x, b_x).astype(jnp.float32))
    log_a = -LRU_C * r * jax.nn.softplus(-lam.astype(jnp.float32))
    a = jnp.exp(log_a)
    mult = jnp.sqrt(-jnp.expm1(2.0 * log_a))
    bx = mult * (i * x.astype(jnp.float32))

    def combine(lhs, rhs):
        a1, b1 = lhs
        a2, b2 = rhs
        return a1 * a2, a2 * b1 + b2

    _, h = lax.associative_scan(combine, (a, bx), axis=1)
    return h.astype(x.dtype)


def setup_inputs(seed: int = 0) -> dict:
    key = jax.random.key(seed)
    ks = jax.random.split(key, 20)
    L = DEPTH
    nrm = jax.random.normal
    x = nrm(ks[0], (BATCH, SEQ, D_MODEL), jnp.float32)
    norm_mix_g = 1.0 + 0.02 * nrm(ks[1], (L, D_MODEL), jnp.float32)
    w_in = nrm(ks[2], (L, D_MODEL, IN_COLS), jnp.float32) * D_MODEL ** -0.5
    conv_w = nrm(ks[3], (L, CONV_K, CONV_WIDTH), jnp.float32) * CONV_K ** -0.5
    rnn_conv_w = nrm(ks[4], (L, LRU_CONV_K, LRU_WIDTH), jnp.float32) * LRU_CONV_K ** -0.5
    rnn_conv_b = 0.01 * nrm(ks[5], (L, LRU_WIDTH), jnp.float32)
    w_a = nrm(ks[6], (L, LRU_HEADS, HEAD_DIM, HEAD_DIM), jnp.float32) * HEAD_DIM ** -0.5
    b_a = 0.01 * nrm(ks[7], (L, LRU_WIDTH), jnp.float32)
    w_x = nrm(ks[8], (L, LRU_HEADS, HEAD_DIM, HEAD_DIM), jnp.float32) * HEAD_DIM ** -0.5
    b_x = 0.01 * nrm(ks[9], (L, LRU_WIDTH), jnp.float32)
    a_c = jax.random.uniform(ks[10], (L, LRU_WIDTH), jnp.float32, 0.9, 0.999)
    s = a_c ** (1.0 / LRU_C)
    lru_lambda = jnp.log(s) - jnp.log1p(-s)
    g_norm_conv = 1.0 + 0.02 * nrm(ks[11], (L, CONV_WIDTH), jnp.float32)
    g_norm_rnn = 1.0 + 0.02 * nrm(ks[12], (L, LRU_WIDTH), jnp.float32)
    w_out = nrm(ks[13], (L, MIX_WIDTH, D_MODEL), jnp.float32) * MIX_WIDTH ** -0.5
    norm_mlp_g = 1.0 + 0.02 * nrm(ks[14], (L, D_MODEL), jnp.float32)
    w_mlp_in = nrm(ks[15], (L, D_MODEL, D_FF), jnp.float32) * D_MODEL ** -0.5
    w_mlp_out = nrm(ks[16], (L, D_FF, D_MODEL), jnp.float32) * D_FF ** -0.5
    final_norm_g = 1.0 + 0.02 * nrm(ks[17], (D_MODEL,), jnp.float32)
    return {"x": x, "norm_mix_g": norm_mix_g, "w_in": w_in, "conv_w": conv_w,
            "rnn_conv_w": rnn_conv_w, "rnn_conv_b": rnn_conv_b,
            "w_a": w_a, "b_a": b_a, "w_x": w_x, "b_x": b_x,
            "lru_lambda": lru_lambda, "g_norm_conv": g_norm_conv,
            "g_norm_rnn": g_norm_rnn, "w_out": w_out, "norm_mlp_g": norm_mlp_g,
            "w_mlp_in": w_mlp_in, "w_mlp_out": w_mlp_out,
            "final_norm_g": final_norm_g}


def reference(x, norm_mix_g, w_in, conv_w, rnn_conv_w, rnn_conv_b, w_a, b_a,
              w_x, b_x, lru_lambda, g_norm_conv, g_norm_rnn, w_out,
              norm_mlp_g, w_mlp_in, w_mlp_out, final_norm_g):
    split_pts = [CONV_WIDTH, 2 * CONV_WIDTH, 3 * CONV_WIDTH,
                 3 * CONV_WIDTH + LRU_WIDTH]
    for l in range(DEPTH):
        h = rmsnorm(x, norm_mix_g[l])
        u = jnp.einsum('bsd,dc->bsc', h, w_in[l])
        gate_b, gate_c, v, x_r, g = jnp.split(u, split_pts, axis=-1)
        y_conv = gate_b * causal_dwconv(gate_c * v, conv_w[l])
        xr = causal_dwconv(x_r, rnn_conv_w[l]) + rnn_conv_b[l]
        y_rnn = rg_lru(xr, w_a[l], b_a[l], w_x[l], b_x[l], lru_lambda[l])
        y_rnn = y_rnn * jax.nn.gelu(g)
        y = jnp.concatenate([rmsnorm(y_conv, g_norm_conv[l]),
                             rmsnorm(y_rnn, g_norm_rnn[l])], axis=-1)
        x = x + jnp.einsum('bsc,cd->bsd', y, w_out[l])
        h = rmsnorm(x, norm_mlp_g[l])
        z = jnp.square(jax.nn.relu(jnp.einsum('bsd,df->bsf', h, w_mlp_in[l])))
        x = x + jnp.einsum('bsf,fd->bsd', z, w_mlp_out[l])
    return rmsnorm(x, final_norm_g)
```

```cpp
#include <hip/hip_runtime.h>
#include <hip/hip_cooperative_groups.h>
#include <cstdio>
#include <cstdint>
namespace cg = cooperative_groups;
namespace pg8 {
#define PG8_LAS __attribute__((address_space(3)))
typedef unsigned short bf16_t;
typedef short bf16x8 __attribute__((ext_vector_type(8)));
typedef float f32x4 __attribute__((ext_vector_type(4)));
typedef unsigned u32x4 __attribute__((ext_vector_type(4)));
constexpr int BM = 256, BK = 64, HALF = 128, HTB = HALF * BK * 2  , STAGE_BYTES = 8 * HTB, NXCD = 8, WGM = 8;

__host__ __device__ __forceinline__ int lds_byte(int r, int c) { const int st = (r >> 4) * 2 + (c >> 5), rr = r & 15, cc = c & 31, ob = rr * 64 + cc * 2; return st * 1024 + (ob ^ (((ob >> 9) & 1) << 5)); }
__host__ __device__ __forceinline__ void stage_rc(int b, int& R, int& C) { const int st = b / 1024, sb = b % 1024, swz = sb ^ (((sb >> 9) & 1) << 5); R = (st >> 1) * 16 + swz / 64; C = (st & 1) * 32 + (swz % 64) / 2; }
__host__ __device__ __forceinline__ int perm32(int rho) { const int n = rho >> 4, i = rho & 15; return 8 * (i >> 2) + 4 * n + (i & 3); }

struct Unit { int pm, pn; };
struct Gemm { const bf16_t* A; const bf16_t* Bt; int M, N, K; };

struct StaticOrder {
    int nM, nN, nwg, G, c;
    __host__ __device__ void init(int M, int N, int G_, int c_) { nM = M / BM; nN = N / BM; nwg = nM * nN; G = G_; c = c_; }
    __host__ __device__ bool next(int i, Unit& u) const {
        const long L = (long)i * G + c; if (L >= nwg) return false;
        int wgid = (int)L; { const int q = nwg / NXCD, r = nwg % NXCD, xcd = wgid % NXCD, off = wgid / NXCD; wgid = (xcd < r ? xcd * (q + 1) : r * (q + 1) + (xcd - r) * q) + off; }
        const int nig = WGM * nN, gid = wgid / nig, fm = gid * WGM, gsz = (nM - fm) < WGM ? (nM - fm) : WGM;
        u.pm = fm + ((wgid % nig) % gsz); u.pn = (wgid % nig) / gsz; return true;
    }
    __device__ __forceinline__ void a_ready(const Unit&) const {}
    __device__ __forceinline__ void done(const Unit&) const {}
};

__device__ __forceinline__ unsigned cvt_pk_bf16(float lo, float hi) { unsigned r; asm volatile("v_cvt_pk_bf16_f32 %0, %1, %2" : "=v"(r) : "v"(lo), "v"(hi)); return r; }
typedef float f32x2 __attribute__((ext_vector_type(2)));
typedef unsigned u32x2 __attribute__((ext_vector_type(2)));
struct EpiStoreBf16 {
    static constexpr bool PERM = true, AFTER_DRAIN = false;
    bf16_t* O; int ldc;
    __device__ __forceinline__ void operator()(const f32x4 (&acc)[2][2][4][2], const Unit& u, int wr, int wc, int fr, int fq) const {
        const int row0 = u.pm * BM + wr * 64 + fr; const int col0 = u.pn * BM + wc * 32 + 8 * fq;
#pragma unroll
        for (int ai = 0; ai < 2; ++ai)
#pragma unroll
            for (int m = 0; m < 4; ++m) { bf16_t* rowp = O + (size_t)(row0 + ai * HALF + m * 16) * ldc + col0;
#pragma unroll
                for (int bj = 0; bj < 2; ++bj) { const f32x4 v0 = acc[ai][bj][m][0], v1 = acc[ai][bj][m][1];
                    u32x4 w; w.x = cvt_pk_bf16(v0[0], v0[1]); w.y = cvt_pk_bf16(v0[2], v0[3]); w.z = cvt_pk_bf16(v1[0], v1[1]); w.w = cvt_pk_bf16(v1[2], v1[3]);
                    *(u32x4*)(rowp + bj * HALF) = w; } }
    }
};
struct EpiRelu2 {
    static constexpr bool PERM = true, AFTER_DRAIN = false;
    bf16_t* O; int ldc; const float* ss; float inv_n, eps;
    __device__ __forceinline__ void operator()(const f32x4 (&acc)[2][2][4][2], const Unit& u, int wr, int wc, int fr, int fq) const {
        const int row0 = u.pm * BM + wr * 64 + fr; const int col0 = u.pn * BM + wc * 32 + 8 * fq;
#pragma unroll
        for (int ai = 0; ai < 2; ++ai)
#pragma unroll
            for (int m = 0; m < 4; ++m) { const int row = row0 + ai * HALF + m * 16;
                const f32x4 p = *(const f32x4*)(ss + (size_t)row * 16 + 4 * fq);
                float s = (p[0] + p[1]) + (p[2] + p[3]); s += __shfl_xor(s, 16); s += __shfl_xor(s, 32);
                const float rstd = 1.0f / sqrtf(s * inv_n + eps);
                bf16_t* rowp = O + (size_t)row * ldc + col0;
#pragma unroll
                for (int bj = 0; bj < 2; ++bj) { f32x4 v0 = acc[ai][bj][m][0] * rstd, v1 = acc[ai][bj][m][1] * rstd;
#pragma unroll
                    for (int e = 0; e < 4; ++e) { const float a0 = fmaxf(v0[e], 0.f), a1 = fmaxf(v1[e], 0.f); v0[e] = a0 * a0; v1[e] = a1 * a1; }
                    u32x4 w; w.x = cvt_pk_bf16(v0[0], v0[1]); w.y = cvt_pk_bf16(v0[2], v0[3]); w.z = cvt_pk_bf16(v1[0], v1[1]); w.w = cvt_pk_bf16(v1[2], v1[3]);
                    *(u32x4*)(rowp + bj * HALF) = w; } }
    }
};
struct EpiResid {
    static constexpr bool PERM = false, AFTER_DRAIN = false;
    const float* base; float* out; bf16_t* xb; const f32x2* rs; float* ss; int ldc;
    __device__ __forceinline__ void rescale(f32x4 (&acc)[2][2][4][2], const Unit& u, int wr, int fr) const {
#pragma unroll
        for (int ai = 0; ai < 2; ++ai)
#pragma unroll
            for (int m = 0; m < 4; ++m) { const int row = u.pm * BM + ai * HALF + wr * 64 + m * 16 + fr; const float f = rs[row].x;
#pragma unroll
                for (int bj = 0; bj < 2; ++bj)
#pragma unroll
                    for (int n = 0; n < 2; ++n) acc[ai][bj][m][n] = acc[ai][bj][m][n] * f; }
    }
    __device__ __forceinline__ void operator()(const f32x4 (&acc)[2][2][4][2], const Unit& u, int wr, int wc, int fr, int fq) const {
        const int col0 = u.pn * BM + wc * 32 + 4 * fq;
#pragma unroll
        for (int ai = 0; ai < 2; ++ai)
#pragma unroll
            for (int m = 0; m < 4; ++m) { const int row = u.pm * BM + ai * HALF + wr * 64 + m * 16 + fr; const size_t off = (size_t)row * ldc + col0;
                const float sc = rs ? rs[row].y : 1.0f; float q = 0.f;
#pragma unroll
                for (int bj = 0; bj < 2; ++bj)
#pragma unroll
                    for (int n = 0; n < 2; ++n) { const f32x4 bs = *(const f32x4*)(base + off + bj * HALF + n * 16); const f32x4 o = bs + acc[ai][bj][m][n] * sc;
                        *(f32x4*)(out + off + bj * HALF + n * 16) = o; q += (o[0] * o[0] + o[1] * o[1]) + (o[2] * o[2] + o[3] * o[3]);
                        if (xb) { u32x2 w; w.x = cvt_pk_bf16(o[0], o[1]); w.y = cvt_pk_bf16(o[2], o[3]); *(u32x2*)(xb + off + bj * HALF + n * 16) = w; } }
                q += __shfl_xor(q, 16); q += __shfl_xor(q, 32);
                if (fq == 0) ss[(size_t)row * 16 + 4 * u.pn + wc] = q;
                if (m & 1) asm volatile("" ::: "memory"); }
    }
};
template <class Epi, class Sched, bool ALIGN_EPI = false, bool SP2 = false, int RST = -1>
__device__ __forceinline__ void gemm_phase(PG8_LAS unsigned char* lds, const Gemm g, const Sched& S, const Epi& E) {
    int tid_ = threadIdx.x; asm volatile("" : "+v"(tid_));
    const int tid = tid_, wid = __builtin_amdgcn_readfirstlane(tid >> 6), lane = tid & 63, wr = wid >> 2, wc = wid & 3, fr = lane & 15, fq = lane >> 4;
    const int K = g.K, nt = K / BK;
    unsigned voffA[2], voffB[2];
#pragma unroll
    for (int i = 0; i < 2; ++i) { int R, C; stage_rc(tid * 16 + i * 8192, R, C); const int Rb = Epi::PERM ? ((R & ~31) + perm32(R & 31)) : R;
        voffA[i] = (unsigned)(R * K + C) * 2u; voffB[i] = (unsigned)(Rb * K + C) * 2u; }
    const size_t kstep = (size_t)(BK * 2);
    const size_t hstep = (size_t)HALF * K * 2;
    const size_t tstep = 2 * hstep;
    const unsigned ldsw = (unsigned)wid * 1024u;
    const int aoff = lds_byte(wr * 64 + fr, fq * 8), boff = lds_byte(wc * 32 + fr, fq * 8);
#define PG8_SA(b, h) (((b) * 2 + (h)) * HTB)
#define PG8_SB(b, h) ((4 + (b) * 2 + (h)) * HTB)
#define PG8_STAGE(bufoff, gbase, voff) do { _Pragma("unroll") for (int _i = 0; _i < 2; ++_i) \
        __builtin_amdgcn_global_load_lds((const unsigned*)((const char*)(gbase) + (voff)[_i]), (PG8_LAS unsigned*)(lds + (bufoff) + ldsw + _i * 8192), 16, 0, 0); } while (0)
#define PG8_LDA(dst, b, h) do { _Pragma("unroll") for (int m = 0; m < 4; ++m) _Pragma("unroll") for (int k = 0; k < 2; ++k) dst[m][k] = *(const PG8_LAS bf16x8*)(lds + PG8_SA(b, h) + aoff + m * 2048 + k * 1024); } while (0)
#define PG8_LDB(dst, b, h) do { _Pragma("unroll") for (int n = 0; n < 2; ++n) _Pragma("unroll") for (int k = 0; k < 2; ++k) dst[n][k] = *(const PG8_LAS bf16x8*)(lds + PG8_SB(b, h) + boff + n * 2048 + k * 1024); } while (0)
#define PG8_MMA(ai, bj, At, Bt) do { __builtin_amdgcn_s_setprio(1); _Pragma("unroll") for (int m = 0; m < 4; ++m) _Pragma("unroll") for (int n = 0; n < 2; ++n) _Pragma("unroll") for (int k = 0; k < 2; ++k) \
        acc[ai][bj][m][n] = __builtin_amdgcn_mfma_f32_16x16x32_bf16(Bt[n][k], At[m][k], acc[ai][bj][m][n], 0, 0, 0); __builtin_amdgcn_s_setprio(0); } while (0)
#define PG8_WAIT_V(n) asm volatile("s_waitcnt vmcnt(" #n ")" ::: "memory")
#define PG8_WAIT_L(n) asm volatile("s_waitcnt lgkmcnt(" #n ")" ::: "memory")
#define PG8_BAR __builtin_amdgcn_s_barrier()
#define PG8_SCHED __builtin_amdgcn_sched_barrier(0)
    Unit cur, nxt; int ui = 0;
    if (!S.next(0, cur)) return;
    f32x4 acc[2][2][4][2];
#pragma unroll
    for (int a = 0; a < 2; ++a)
#pragma unroll
        for (int b = 0; b < 2; ++b)
#pragma unroll
            for (int m = 0; m < 4; ++m)
#pragma unroll
                for (int n = 0; n < 2; ++n) acc[a][b][m][n] = (f32x4){0.f, 0.f, 0.f, 0.f};
    bf16x8 At[4][2], B0[2][2], B1[2][2];
    const char* cA = (const char*)g.A + (size_t)cur.pm * tstep; const char* cB = (const char*)g.Bt + (size_t)cur.pn * tstep;
    S.a_ready(cur);
    if constexpr (SP2) {
        PG8_STAGE(PG8_SB(0, 0), cB, voffB); PG8_STAGE(PG8_SB(0, 1), cB + hstep, voffB); PG8_STAGE(PG8_SA(0, 0), cA, voffA); PG8_STAGE(PG8_SA(0, 1), cA + hstep, voffA);
        if (wr == 1) PG8_BAR;
        PG8_WAIT_V(2); PG8_BAR;
        PG8_STAGE(PG8_SB(1, 0), cB + kstep, voffB); PG8_STAGE(PG8_SA(1, 0), cA + kstep, voffA); PG8_STAGE(PG8_SB(1, 1), cB + hstep + kstep, voffB);
        PG8_WAIT_V(6); PG8_BAR;
    } else {
        PG8_STAGE(PG8_SB(0, 0), cB, voffB); PG8_STAGE(PG8_SA(0, 0), cA, voffA); PG8_STAGE(PG8_SB(0, 1), cB + hstep, voffB); PG8_STAGE(PG8_SA(0, 1), cA + hstep, voffA);
        if (wr == 1) PG8_BAR;
        PG8_WAIT_V(4); PG8_BAR;
        PG8_STAGE(PG8_SB(1, 0), cB + kstep, voffB); PG8_STAGE(PG8_SA(1, 0), cA + kstep, voffA); PG8_STAGE(PG8_SB(1, 1), cB + hstep + kstep, voffB);
        PG8_WAIT_V(6); PG8_BAR;
    }
    for (;;) {
        const bool has_next = S.next(ui + 1, nxt);
        const char* nA = has_next ? (const char*)g.A + (size_t)nxt.pm * tstep : cA; const char* nB = has_next ? (const char*)g.Bt + (size_t)nxt.pn * tstep : cB;
        for (int t = 0; t < nt; t += 2) {
            const bool last = (t == nt - 2);
            if constexpr (RST >= 0) { if (t == RST) E.rescale(acc, cur, wr, fr); }
            const char* a1 = cA + (size_t)(t + 1) * kstep;
            const char* a2 = last ? nA : cA + (size_t)(t + 2) * kstep; const char* b2 = last ? nB : cB + (size_t)(t + 2) * kstep;
            const char* a3 = a2 + kstep; const char* b3 = b2 + kstep;
            if (last && has_next) S.a_ready(nxt);
            if constexpr (SP2) {
            PG8_LDB(B0, 0, 0); PG8_LDB(B1, 0, 1); PG8_SCHED; PG8_LDA(At, 0, 0); PG8_STAGE(PG8_SA(1, 1), a1 + hstep, voffA);
            PG8_WAIT_V(8); PG8_WAIT_L(0); PG8_BAR; PG8_MMA(0, 0, At, B0); PG8_MMA(0, 1, At, B1); PG8_BAR; PG8_SCHED;
            PG8_LDA(At, 0, 1); PG8_STAGE(PG8_SB(0, 0), b2, voffB); PG8_STAGE(PG8_SB(0, 1), b2 + hstep, voffB); PG8_STAGE(PG8_SA(0, 0), a2, voffA);
            PG8_WAIT_V(8); PG8_WAIT_L(0); PG8_BAR; PG8_MMA(1, 0, At, B0); PG8_MMA(1, 1, At, B1); PG8_BAR; PG8_SCHED;
            PG8_LDB(B0, 1, 0); PG8_LDB(B1, 1, 1); PG8_SCHED; PG8_LDA(At, 1, 0); PG8_STAGE(PG8_SA(0, 1), a2 + hstep, voffA);
            PG8_WAIT_V(8); PG8_WAIT_L(0); PG8_BAR; PG8_MMA(0, 0, At, B0); PG8_MMA(0, 1, At, B1); PG8_BAR; PG8_SCHED;
            PG8_LDA(At, 1, 1); PG8_STAGE(PG8_SB(1, 0), b3, voffB); PG8_STAGE(PG8_SB(1, 1), b3 + hstep, voffB); PG8_STAGE(PG8_SA(1, 0), a3, voffA);
            PG8_WAIT_V(8); PG8_WAIT_L(0); PG8_BAR; PG8_MMA(1, 0, At, B0); PG8_MMA(1, 1, At, B1); PG8_BAR; PG8_SCHED;
            } else {
            PG8_LDB(B0, 0, 0); PG8_SCHED; PG8_LDA(At, 0, 0); PG8_STAGE(PG8_SA(1, 1), a1 + hstep, voffA);
            PG8_WAIT_L(8); PG8_BAR; PG8_WAIT_L(0); PG8_MMA(0, 0, At, B0); PG8_BAR; PG8_SCHED;
            PG8_LDB(B1, 0, 1); PG8_STAGE(PG8_SB(0, 0), b2, voffB);
            PG8_BAR; PG8_WAIT_L(0); PG8_MMA(0, 1, At, B1); PG8_BAR;
            PG8_LDA(At, 0, 1); PG8_STAGE(PG8_SA(0, 0), a2, voffA);
            PG8_BAR; PG8_WAIT_L(0); PG8_MMA(1, 0, At, B0); PG8_BAR; PG8_SCHED;
            PG8_STAGE(PG8_SB(0, 1), b2 + hstep, voffB);
            PG8_WAIT_V(6); PG8_BAR; PG8_MMA(1, 1, At, B1); PG8_BAR;
            PG8_LDB(B0, 1, 0); PG8_SCHED; PG8_LDA(At, 1, 0); PG8_STAGE(PG8_SA(0, 1), a2 + hstep, voffA);
            PG8_WAIT_L(8); PG8_BAR; PG8_WAIT_L(0); PG8_MMA(0, 0, At, B0); PG8_BAR; PG8_SCHED;
            PG8_LDB(B1, 1, 1); PG8_STAGE(PG8_SB(1, 0), b3, voffB);
            PG8_BAR; PG8_WAIT_L(0); PG8_MMA(0, 1, At, B1); PG8_BAR;
            PG8_LDA(At, 1, 1); PG8_STAGE(PG8_SA(1, 0), a3, voffA);
            PG8_BAR; PG8_WAIT_L(0); PG8_MMA(1, 0, At, B0); PG8_BAR; PG8_SCHED;
            PG8_STAGE(PG8_SB(1, 1), b3 + hstep, voffB);
            PG8_WAIT_V(6); PG8_BAR; PG8_MMA(1, 1, At, B1); PG8_BAR;
            }
        }
        if constexpr (ALIGN_EPI) { if (wr == 0) PG8_BAR; }
        if constexpr (!Epi::AFTER_DRAIN) { E(acc, cur, wr, wc, fr, fq); S.done(cur); }
        if (!has_next) break;
#pragma unroll
        for (int a = 0; a < 2; ++a)
#pragma unroll
            for (int b = 0; b < 2; ++b)
#pragma unroll
                for (int m = 0; m < 4; ++m)
#pragma unroll
                    for (int n = 0; n < 2; ++n) acc[a][b][m][n] = (f32x4){0.f, 0.f, 0.f, 0.f};
        cur = nxt; cA = nA; cB = nB; ++ui;
        if constexpr (ALIGN_EPI) { if (wr == 1) PG8_BAR; }
    }
    PG8_WAIT_V(0);
    if constexpr (!ALIGN_EPI) { if (wr == 0) PG8_BAR; }
    PG8_BAR;
    if constexpr (Epi::AFTER_DRAIN) { E.fused(acc, cur, wr, wc, fr, fq, lds, wid, lane); S.done(cur); }
#undef PG8_SA
#undef PG8_SB
#undef PG8_STAGE
#undef PG8_LDA
#undef PG8_LDB
#undef PG8_MMA
#undef PG8_WAIT_V
#undef PG8_WAIT_L
#undef PG8_BAR
#undef PG8_SCHED
}
}
constexpr int NWAVES = 8;
constexpr int BATCH = 8, SEQ = 4096, D = 1024, CW = 512, LW = 1024, MIXW = CW + LW, INC = 3 * CW + 2 * LW, FF = 4096, NH = 16;
constexpr int M = BATCH * SEQ;
constexpr int COL_GB = 0, COL_GC = CW, COL_V = 2 * CW, COL_XR = 3 * CW, COL_G = 3 * CW + LW;
constexpr float EPS = 1e-6f;
constexpr int TCH = 128, NCHUNK = SEQ / TCH;
constexpr size_t MiB = 1u << 20;
constexpr size_t WS_WIN = 2 * MiB, WS_WOUT = 10 * MiB, WS_W1 = 14 * MiB, WS_W2 = 22 * MiB;
constexpr size_t WS_WF = 30 * MiB;
constexpr size_t WS_NSP = 30 * MiB + 512 * 1024;
constexpr size_t WS_SUMA = 31 * MiB, WS_SUMH = 32 * MiB;
constexpr size_t WS_RS = 33 * MiB;
constexpr size_t WS_SS1 = 34 * MiB, WS_SS2 = 36 * MiB;
constexpr size_t WS_XN = 40 * MiB;
constexpr size_t WS_U = 104 * MiB;
constexpr size_t WS_Y = 328 * MiB;
constexpr size_t WS_Z = 104 * MiB;
constexpr size_t WS_END = 424 * MiB;
static_assert(WS_XN + (size_t)M * D * 2 <= WS_U && WS_U + (size_t)M * INC * 2 <= WS_Y && WS_Y + (size_t)M * MIXW * 2 <= WS_END && WS_Z + (size_t)M * FF * 2 <= WS_END, "d_ws map");
static_assert(WS_WIN + (size_t)INC * D * 2 <= WS_WOUT && WS_WOUT + (size_t)D * MIXW * 2 <= WS_W1 && WS_W1 + (size_t)FF * D * 2 <= WS_W2 && WS_W2 + (size_t)FF * D * 2 <= WS_WF, "weights map");
constexpr int RING_BYTES = 131072;
constexpr int LDS_BYTES = 147456;
constexpr int L_RCW = 0, L_RCB = 16384, L_BA = 20480, L_BX = 24576, L_NSP = 28672, L_CW = 32768, L_SSA = 38912, L_SSB = 43008, L_MIX_END = 51200;

#define LAS __attribute__((address_space(3)))
typedef unsigned short bf16;
typedef unsigned v4u __attribute__((ext_vector_type(4)));
typedef float f32x4 __attribute__((ext_vector_type(4)));
typedef float f32x2 __attribute__((ext_vector_type(2)));
typedef short bf16x8 __attribute__((ext_vector_type(8)));
#define LDS_WAIT() asm volatile("s_waitcnt lgkmcnt(0)" ::: "memory")
__device__ __forceinline__ unsigned pk2(float lo, float hi) { return pg8::cvt_pk_bf16(lo, hi); }
__device__ __forceinline__ float bf_lo(unsigned u) { return __builtin_bit_cast(float, u << 16); }
__device__ __forceinline__ float bf_hi(unsigned u) { return __builtin_bit_cast(float, u & 0xffff0000u); }
__device__ __forceinline__ float wave_sum(float v) {
#pragma unroll
    for (int o = 1; o < 64; o <<= 1) v += __shfl_xor(v, o);
    return v;
}
template <int CTRL> __device__ __forceinline__ float dppf(float oldv, float v) {
    return __builtin_bit_cast(float, __builtin_amdgcn_update_dpp(__builtin_bit_cast(int, oldv), __builtin_bit_cast(int, v), CTRL, 0xf, 0xf, false));
}
__device__ __forceinline__ float sigm(float x) { return __builtin_amdgcn_rcpf(1.0f + __expf(-x)); }

struct Args { const float* in[18]; float* out; unsigned char* ws; };
enum { I_X = 0, I_GMIX, I_WIN, I_CONVW, I_RCW, I_RCB, I_WA, I_BA, I_WX, I_BX, I_LAM, I_GCONV, I_GRNN, I_WOUT, I_GMLP, I_W1, I_W2, I_GFIN };

__device__ __forceinline__ void p0_transpose_item(const float* W, int K, int N, bf16* WT, LAS float* scr, int item, int lane, const float* g0, const float* g1, int split) {
    const int nblk = N / 32, kb = item / nblk, nb = item % nblk, k0 = 64 * kb, n0 = 32 * nb;
#pragma unroll 8
    for (int i = 0; i < 32; ++i) { const int kk = 2 * i + (lane >> 5); const int k = k0 + kk;
        const float gn = g0 ? (k < split ? g0[k] : g1[k - split]) : 1.0f;
        scr[kk * 33 + (lane & 31)] = W[(size_t)k * N + n0 + (lane & 31)] * gn; }
    LDS_WAIT(); asm volatile("" ::: "memory");
    const int c = lane & 7;
#pragma unroll
    for (int j = 0; j < 4; ++j) { const int n = (lane >> 3) + 8 * j; const LAS float* s = scr + (8 * c) * 33 + n;
        v4u o; o.x = pk2(s[0 * 33], s[1 * 33]); o.y = pk2(s[2 * 33], s[3 * 33]); o.z = pk2(s[4 * 33], s[5 * 33]); o.w = pk2(s[6 * 33], s[7 * 33]);
        *(v4u*)(WT + (size_t)(n0 + n) * K + k0 + 8 * c) = o; }
    LDS_WAIT(); asm volatile("" ::: "memory");
}

struct MixP { const bf16* U; const bf16* WF; bf16* Y; float* SUMA; float* SUMH; f32x2* RS; };

template <int PASS>
__device__ __forceinline__ void mixer_unit(LAS unsigned char* lds, const MixP& P, int b, int c, int wave, int lane, int tid) {
    asm volatile("" : "+v"(lane), "+v"(tid));
    const int fr = lane & 15, fq = lane >> 4;
    const size_t rowbase = (size_t)b * SEQ;
#pragma unroll 1
    for (int hl = 0; hl < 2; ++hl) {
        const int h = wave * 2 + hl, ch0 = 64 * h + 16 * fq;
        bf16x8 WA[4][2], WX[4][2];
#pragma unroll
        for (int n = 0; n < 4; ++n)
#pragma unroll
            for (int s = 0; s < 2; ++s) {
                WA[n][s] = *(const bf16x8*)(P.WF + ((size_t)((((h * 2 + 0) * 4 + n) * 2 + s) * 64 + lane)) * 8);
                WX[n][s] = *(const bf16x8*)(P.WF + ((size_t)((((h * 2 + 1) * 4 + n) * 2 + s) * 64 + lane)) * 8); }
        float hc[16], ac[16];
#pragma unroll
        for (int i = 0; i < 16; ++i) { hc[i] = 0.f; ac[i] = 1.f; }
        if (PASS == 1) {
            for (int j = 0; j < c; ++j) { const size_t o = ((size_t)(b * NCHUNK + j)) * LW + ch0;
#pragma unroll
                for (int q = 0; q < 4; ++q) { const f32x4 A4 = *(const f32x4*)(P.SUMA + o + 4 * q), H4 = *(const f32x4*)(P.SUMH + o + 4 * q);
#pragma unroll
                    for (int e = 0; e < 4; ++e) hc[4 * q + e] = fmaf(A4[e], hc[4 * q + e], H4[e]); } }
        }
#pragma unroll 1
        for (int m = 0; m < TCH / 16; ++m) {
            const int tpos = c * TCH + 16 * m + fr;
            float xr[16];
            { const LAS f32x4* tb = (const LAS f32x4*)(lds + L_RCB + ch0 * 4);
#pragma unroll
              for (int q = 0; q < 4; ++q) { const f32x4 v = tb[q]; xr[4 * q] = v[0]; xr[4 * q + 1] = v[1]; xr[4 * q + 2] = v[2]; xr[4 * q + 3] = v[3]; } }
#pragma unroll
            for (int k = 0; k < 4; ++k) {
                const int tt = tpos - 3 + k; const bool ok = tt >= 0; const size_t row = rowbase + (size_t)(ok ? tt : 0);
                const v4u* src = (const v4u*)(P.U + row * INC + COL_XR + ch0);
                v4u v0 = src[0], v1 = src[1];
                if (!ok) { v0 = (v4u){0u, 0u, 0u, 0u}; v1 = v0; }
                const LAS f32x4* tw = (const LAS f32x4*)(lds + L_RCW + (k * LW + ch0) * 4);
                const f32x4 w0 = tw[0], w1 = tw[1], w2 = tw[2], w3 = tw[3];
                xr[0] = fmaf(w0[0], bf_lo(v0.x), xr[0]); xr[1] = fmaf(w0[1], bf_hi(v0.x), xr[1]); xr[2] = fmaf(w0[2], bf_lo(v0.y), xr[2]); xr[3] = fmaf(w0[3], bf_hi(v0.y), xr[3]);
                xr[4] = fmaf(w1[0], bf_lo(v0.z), xr[4]); xr[5] = fmaf(w1[1], bf_hi(v0.z), xr[5]); xr[6] = fmaf(w1[2], bf_lo(v0.w), xr[6]); xr[7] = fmaf(w1[3], bf_hi(v0.w), xr[7]);
                xr[8] = fmaf(w2[0], bf_lo(v1.x), xr[8]); xr[9] = fmaf(w2[1], bf_hi(v1.x), xr[9]); xr[10] = fmaf(w2[2], bf_lo(v1.y), xr[10]); xr[11] = fmaf(w2[3], bf_hi(v1.y), xr[11]);
                xr[12] = fmaf(w3[0], bf_lo(v1.z), xr[12]); xr[13] = fmaf(w3[1], bf_hi(v1.z), xr[13]); xr[14] = fmaf(w3[2], bf_lo(v1.w), xr[14]); xr[15] = fmaf(w3[3], bf_hi(v1.w), xr[15]);
            }
            v4u gg0, gg1;
            if (PASS == 1) { const v4u* gs = (const v4u*)(P.U + (rowbase + tpos) * INC + COL_G + ch0); gg0 = gs[0]; gg1 = gs[1]; }
            v4u xb0, xb1;
            xb0.x = pk2(xr[0], xr[1]); xb0.y = pk2(xr[2], xr[3]); xb0.z = pk2(xr[4], xr[5]); xb0.w = pk2(xr[6], xr[7]);
            xb1.x = pk2(xr[8], xr[9]); xb1.y = pk2(xr[10], xr[11]); xb1.z = pk2(xr[12], xr[13]); xb1.w = pk2(xr[14], xr[15]);
            const bf16x8 X0 = __builtin_bit_cast(bf16x8, xb0), X1 = __builtin_bit_cast(bf16x8, xb1);
            f32x4 aA[4], aX[4];
#pragma unroll
            for (int n = 0; n < 4; ++n) {
                aA[n] = (f32x4){0.f, 0.f, 0.f, 0.f}; aX[n] = (f32x4){0.f, 0.f, 0.f, 0.f};
                aA[n] = __builtin_amdgcn_mfma_f32_16x16x32_bf16(WA[n][0], X0, aA[n], 0, 0, 0); aA[n] = __builtin_amdgcn_mfma_f32_16x16x32_bf16(WA[n][1], X1, aA[n], 0, 0, 0);
                aX[n] = __builtin_amdgcn_mfma_f32_16x16x32_bf16(WX[n][0], X0, aX[n], 0, 0, 0); aX[n] = __builtin_amdgcn_mfma_f32_16x16x32_bf16(WX[n][1], X1, aX[n], 0, 0, 0);
            }
            float y[16]; float q2 = 0.f;
#pragma unroll
            for (int n = 0; n < 4; ++n) {
                const f32x4 ba4 = *(const LAS f32x4*)(lds + L_BA + (ch0 + 4 * n) * 4), bx4 = *(const LAS f32x4*)(lds + L_BX + (ch0 + 4 * n) * 4), ns4 = *(const LAS f32x4*)(lds + L_NSP + (ch0 + 4 * n) * 4);
#pragma unroll
                for (int j = 0; j < 4; ++j) {
                    const int i = 4 * n + j;
                    const float r = sigm(aA[n][j] + ba4[j]), ig = sigm(aX[n][j] + bx4[j]);
                    const float la = ns4[j] * r; const float av = __expf(la); const float mult = sqrtf(-expm1f(2.0f * la));
                    float bv = mult * ig * xr[i];
                    const float hp = dppf<0x121>(0.f, hc[i]);
                    bv = (fr == 0) ? fmaf(av, hp, bv) : bv;
                    float A = av;
                    if (PASS == 0) { const float ap = dppf<0x121>(1.f, ac[i]); A = (fr == 0) ? av * ap : av; }
                    { const float Bs = dppf<0x111>(0.f, bv), As = dppf<0x111>(1.f, A); bv = fmaf(A, Bs, bv); A *= As; }
                    { const float Bs = dppf<0x112>(0.f, bv), As = dppf<0x112>(1.f, A); bv = fmaf(A, Bs, bv); A *= As; }
                    { const float Bs = dppf<0x114>(0.f, bv), As = dppf<0x114>(1.f, A); bv = fmaf(A, Bs, bv); A *= As; }
                    { const float Bs = dppf<0x118>(0.f, bv), As = dppf<0x118>(1.f, A); bv = fmaf(A, Bs, bv); A *= As; }
                    hc[i] = bv; if (PASS == 0) ac[i] = A;
                    if (PASS == 1) {
                        const unsigned gw_ = (i < 8) ? ((i >> 1) == 0 ? gg0.x : (i >> 1) == 1 ? gg0.y : (i >> 1) == 2 ? gg0.z : gg0.w) : (((i - 8) >> 1) == 0 ? gg1.x : ((i - 8) >> 1) == 1 ? gg1.y : ((i - 8) >> 1) == 2 ? gg1.z : gg1.w);
                        const float g = (i & 1) ? bf_hi(gw_) : bf_lo(gw_);
                        const float u3 = 1.5957691216f * (g + 0.044715f * g * g * g);
                        const float yv = bv * (g * sigm(u3));
                        y[i] = yv; q2 = fmaf(yv, yv, q2);
                    }
                }
            }
            if (PASS == 1) {
                v4u o0, o1;
                o0.x = pk2(y[0], y[1]); o0.y = pk2(y[2], y[3]); o0.z = pk2(y[4], y[5]); o0.w = pk2(y[6], y[7]);
                o1.x = pk2(y[8], y[9]); o1.y = pk2(y[10], y[11]); o1.z = pk2(y[12], y[13]); o1.w = pk2(y[14], y[15]);
                v4u* dst = (v4u*)(P.Y + (rowbase + tpos) * MIXW + CW + ch0); dst[0] = o0; dst[1] = o1;
                q2 += __shfl_xor(q2, 16); q2 += __shfl_xor(q2, 32);
                if (fq == 0) ((LAS float*)(lds + L_SSB))[(16 * m + fr) * 16 + h] = q2;
            }
        }
        if (PASS == 0) {
            if (fr == 15) { const size_t o = ((size_t)(b * NCHUNK + c)) * LW + ch0;
#pragma unroll
                for (int q = 0; q < 4; ++q) { *(f32x4*)(P.SUMA + o + 4 * q) = (f32x4){ac[4 * q], ac[4 * q + 1], ac[4 * q + 2], ac[4 * q + 3]};
                                              *(f32x4*)(P.SUMH + o + 4 * q) = (f32x4){hc[4 * q], hc[4 * q + 1], hc[4 * q + 2], hc[4 * q + 3]}; } }
        }
    }
    if (PASS == 1) {
        const int ca0 = 64 * wave + 16 * fq;
#pragma unroll 1
        for (int m = 0; m < TCH / 16; ++m) {
            const int tpos = c * TCH + 16 * m + fr;
            float acc[16];
#pragma unroll
            for (int i = 0; i < 16; ++i) acc[i] = 0.f;
#pragma unroll
            for (int k = 0; k < 3; ++k) {
                const int tt = tpos - 2 + k; const bool ok = tt >= 0; const size_t row = rowbase + (size_t)(ok ? tt : 0);
                const v4u* sc = (const v4u*)(P.U + row * INC + COL_GC + ca0); const v4u* sv = (const v4u*)(P.U + row * INC + COL_V + ca0);
                v4u c0 = sc[0], c1 = sc[1]; const v4u v0 = sv[0], v1 = sv[1];
                if (!ok) { c0 = (v4u){0u, 0u, 0u, 0u}; c1 = c0; }
                const LAS f32x4* tw = (const LAS f32x4*)(lds + L_CW + (k * CW + ca0) * 4);
                const f32x4 w0 = tw[0], w1 = tw[1], w2 = tw[2], w3 = tw[3];
                acc[0] = fmaf(w0[0], bf_lo(c0.x) * bf_lo(v0.x), acc[0]); acc[1] = fmaf(w0[1], bf_hi(c0.x) * bf_hi(v0.x), acc[1]); acc[2] = fmaf(w0[2], bf_lo(c0.y) * bf_lo(v0.y), acc[2]); acc[3] = fmaf(w0[3], bf_hi(c0.y) * bf_hi(v0.y), acc[3]);
                acc[4] = fmaf(w1[0], bf_lo(c0.z) * bf_lo(v0.z), acc[4]); acc[5] = fmaf(w1[1], bf_hi(c0.z) * bf_hi(v0.z), acc[5]); acc[6] = fmaf(w1[2], bf_lo(c0.w) * bf_lo(v0.w), acc[6]); acc[7] = fmaf(w1[3], bf_hi(c0.w) * bf_hi(v0.w), acc[7]);
                acc[8] = fmaf(w2[0], bf_lo(c1.x) * bf_lo(v1.x), acc[8]); acc[9] = fmaf(w2[1], bf_hi(c1.x) * bf_hi(v1.x), acc[9]); acc[10] = fmaf(w2[2], bf_lo(c1.y) * bf_lo(v1.y), acc[10]); acc[11] = fmaf(w2[3], bf_hi(c1.y) * bf_hi(v1.y), acc[11]);
                acc[12] = fmaf(w3[0], bf_lo(c1.z) * bf_lo(v1.z), acc[12]); acc[13] = fmaf(w3[1], bf_hi(c1.z) * bf_hi(v1.z), acc[13]); acc[14] = fmaf(w3[2], bf_lo(c1.w) * bf_lo(v1.w), acc[14]); acc[15] = fmaf(w3[3], bf_hi(c1.w) * bf_hi(v1.w), acc[15]);
            }
            const v4u* sb = (const v4u*)(P.U + (rowbase + tpos) * INC + COL_GB + ca0); const v4u b0 = sb[0], b1 = sb[1];
            float y[16];
            y[0] = bf_lo(b0.x) * acc[0]; y[1] = bf_hi(b0.x) * acc[1]; y[2] = bf_lo(b0.y) * acc[2]; y[3] = bf_hi(b0.y) * acc[3]; y[4] = bf_lo(b0.z) * acc[4]; y[5] = bf_hi(b0.z) * acc[5]; y[6] = bf_lo(b0.w) * acc[6]; y[7] = bf_hi(b0.w) * acc[7];
            y[8] = bf_lo(b1.x) * acc[8]; y[9] = bf_hi(b1.x) * acc[9]; y[10] = bf_lo(b1.y) * acc[10]; y[11] = bf_hi(b1.y) * acc[11]; y[12] = bf_lo(b1.z) * acc[12]; y[13] = bf_hi(b1.z) * acc[13]; y[14] = bf_lo(b1.w) * acc[14]; y[15] = bf_hi(b1.w) * acc[15];
            float q2 = 0.f;
#pragma unroll
            for (int i = 0; i < 16; ++i) q2 = fmaf(y[i], y[i], q2);
            v4u o0, o1;
            o0.x = pk2(y[0], y[1]); o0.y = pk2(y[2], y[3]); o0.z = pk2(y[4], y[5]); o0.w = pk2(y[6], y[7]);
            o1.x = pk2(y[8], y[9]); o1.y = pk2(y[10], y[11]); o1.z = pk2(y[12], y[13]); o1.w = pk2(y[14], y[15]);
            v4u* dst = (v4u*)(P.Y + (rowbase + tpos) * MIXW + ca0); dst[0] = o0; dst[1] = o1;
            q2 += __shfl_xor(q2, 16); q2 += __shfl_xor(q2, 32);
            if (fq == 0) ((LAS float*)(lds + L_SSA))[(16 * m + fr) * 8 + wave] = q2;
        }
        __syncthreads();
        if (tid < TCH) {
            const LAS float* sa = (const LAS float*)(lds + L_SSA) + tid * 8; const LAS float* sb = (const LAS float*)(lds + L_SSB) + tid * 16;
            float a = 0.f, bsum = 0.f;
#pragma unroll
            for (int i = 0; i < 8; ++i) a += sa[i];
#pragma unroll
            for (int i = 0; i < 16; ++i) bsum += sb[i];
            const float rA = 1.0f / sqrtf(a * (1.0f / CW) + EPS), rB = 1.0f / sqrtf(bsum * (1.0f / LW) + EPS);
            P.RS[rowbase + (size_t)c * TCH + tid] = (f32x2){rA / rB, rB};
        }
        __syncthreads();
    }
}

__global__ void __launch_bounds__(NWAVES * 64, 2) hybrid_fwd(Args args) {
    extern __shared__ __attribute__((aligned(16))) unsigned char lds_raw[];
    LAS unsigned char* lds = (LAS unsigned char*)lds_raw;
    cg::grid_group grid = cg::this_grid();
    const int tid = threadIdx.x, lane = tid & 63, wave = __builtin_amdgcn_readfirstlane(tid >> 6);
    const int G = gridDim.x; const int bx = blockIdx.x; const int vcu = (G % 8 == 0) ? (bx % 8) * (G / 8) + bx / 8 : bx;
    unsigned char* ws = args.ws;
    const float* x = args.in[I_X]; float* out = args.out;
    bf16* Win_t = (bf16*)(ws + WS_WIN); bf16* Wout_t = (bf16*)(ws + WS_WOUT); bf16* W1_t = (bf16*)(ws + WS_W1); bf16* W2_t = (bf16*)(ws + WS_W2);
    bf16* WF = (bf16*)(ws + WS_WF); float* NSP = (float*)(ws + WS_NSP); float* SUMA = (float*)(ws + WS_SUMA); float* SUMH = (float*)(ws + WS_SUMH);
    f32x2* RS = (f32x2*)(ws + WS_RS); float* SS1 = (float*)(ws + WS_SS1); float* SS2 = (float*)(ws + WS_SS2);
    bf16* XN = (bf16*)(ws + WS_XN); bf16* U = (bf16*)(ws + WS_U); bf16* Y = (bf16*)(ws + WS_Y); bf16* Z = (bf16*)(ws + WS_Z);
    const int gw = vcu * NWAVES + wave, NGW = G * NWAVES;

    {
        LAS float* scr = (LAS float*)(lds + wave * 16384);
        constexpr int I_IN = (D / 64) * (INC / 32), I_OUT = (MIXW / 64) * (D / 32), I_1 = (D / 64) * (FF / 32), I_2 = (FF / 64) * (D / 32);
        constexpr int NITEMS = I_IN + I_OUT + I_1 + I_2;
        for (int it = gw; it < NITEMS; it += NGW) {
            int r = it;
            if (r < I_IN) { p0_transpose_item(args.in[I_WIN], D, INC, Win_t, scr, r, lane, nullptr, nullptr, 0); continue; } r -= I_IN;
            if (r < I_OUT) { p0_transpose_item(args.in[I_WOUT], MIXW, D, Wout_t, scr, r, lane, args.in[I_GCONV], args.in[I_GRNN], CW); continue; } r -= I_OUT;
            if (r < I_1) { p0_transpose_item(args.in[I_W1], D, FF, W1_t, scr, r, lane, args.in[I_GMLP], args.in[I_GMLP], D); continue; } r -= I_1;
            p0_transpose_item(args.in[I_W2], FF, D, W2_t, scr, r, lane, nullptr, nullptr, 0);
        }
        for (int idx = vcu * (NWAVES * 64) + tid; idx < NH * 2 * 4 * 2 * 64; idx += G * NWAVES * 64) {
            const int ln = idx & 63, s = (idx >> 6) & 1, n = (idx >> 7) & 3, gate = (idx >> 9) & 1, h = idx >> 10;
            const int r = ln & 15, fqp = ln >> 4, oc = 16 * (r >> 2) + 4 * n + (r & 3);
            const float* w = (gate ? args.in[I_WX] : args.in[I_WA]) + (size_t)h * 4096 + oc;
            float v[8];
#pragma unroll
            for (int j = 0; j < 8; ++j) v[j] = w[(16 * fqp + 8 * s + j) * 64];
            v4u o; o.x = pk2(v[0], v[1]); o.y = pk2(v[2], v[3]); o.z = pk2(v[4], v[5]); o.w = pk2(v[6], v[7]);
            *(v4u*)(WF + (size_t)idx * 8) = o;
        }
        for (int idx = vcu * (NWAVES * 64) + tid; idx < LW; idx += G * NWAVES * 64) NSP[idx] = -8.0f * log1pf(expf(-args.in[I_LAM][idx]));
        { const float* gm = args.in[I_GMIX]; f32x4 gv[4];
#pragma unroll
          for (int j = 0; j < 4; ++j) gv[j] = *((const f32x4*)gm + lane + 64 * j);
          for (int m = gw; m < M; m += NGW) {
            const f32x4* xr = (const f32x4*)(x + (size_t)m * D) + lane; f32x4 v[4]; float s2 = 0.f;
#pragma unroll
            for (int j = 0; j < 4; ++j) { v[j] = xr[64 * j]; s2 += (v[j].x * v[j].x + v[j].y * v[j].y) + (v[j].z * v[j].z + v[j].w * v[j].w); }
            const float rstd = 1.0f / sqrtf(wave_sum(s2) * (1.0f / D) + EPS);
            unsigned long long* o8 = (unsigned long long*)(XN + (size_t)m * D) + lane;
#pragma unroll
            for (int j = 0; j < 4; ++j) o8[64 * j] = (unsigned long long)pk2(v[j].x * rstd * gv[j].x, v[j].y * rstd * gv[j].y) | ((unsigned long long)pk2(v[j].z * rstd * gv[j].z, v[j].w * rstd * gv[j].w) << 32);
          } }
    }
    grid.sync();

    {
        pg8::Gemm g{XN, Win_t, M, INC, D}; pg8::StaticOrder S; S.init(M, INC, G, bx);
        pg8::EpiStoreBf16 E{U, INC};
        pg8::gemm_phase<pg8::EpiStoreBf16, pg8::StaticOrder, true, true>(lds, g, S, E);
    }
    grid.sync();

    {
        for (int i = tid; i < 4 * LW; i += NWAVES * 64) ((LAS float*)(lds + L_RCW))[i] = args.in[I_RCW][i];
        for (int i = tid; i < LW; i += NWAVES * 64) { ((LAS float*)(lds + L_RCB))[i] = args.in[I_RCB][i]; ((LAS float*)(lds + L_BA))[i] = args.in[I_BA][i]; ((LAS float*)(lds + L_BX))[i] = args.in[I_BX][i]; ((LAS float*)(lds + L_NSP))[i] = NSP[i]; }
        for (int i = tid; i < 3 * CW; i += NWAVES * 64) ((LAS float*)(lds + L_CW))[i] = args.in[I_CONVW][i];
        __syncthreads();
        const MixP P{U, WF, Y, SUMA, SUMH, RS};
        for (int u = vcu; u < BATCH * NCHUNK; u += G) mixer_unit<0>(lds, P, u / NCHUNK, u % NCHUNK, wave, lane, tid);
        grid.sync();
        for (int u = vcu; u < BATCH * NCHUNK; u += G) mixer_unit<1>(lds, P, u / NCHUNK, u % NCHUNK, wave, lane, tid);
    }
    grid.sync();

    {
        pg8::Gemm g{Y, Wout_t, M, D, MIXW}; pg8::StaticOrder S; S.init(M, D, G, bx);
        pg8::EpiResid E{x, out, XN, (const pg8::f32x2*)RS, SS1, D};
        pg8::gemm_phase<pg8::EpiResid, pg8::StaticOrder, true, true, CW / 64>(lds, g, S, E);
    }
    grid.sync();

    {
        pg8::Gemm g{XN, W1_t, M, FF, D}; pg8::StaticOrder S; S.init(M, FF, G, bx);
        pg8::EpiRelu2 E{Z, FF, SS1, 1.0f / D, EPS};
        pg8::gemm_phase<pg8::EpiRelu2, pg8::StaticOrder, true, true>(lds, g, S, E);
    }
    grid.sync();

    {
        pg8::Gemm g{Z, W2_t, M, D, FF}; pg8::StaticOrder S; S.init(M, D, G, bx);
        pg8::EpiResid E{out, out, nullptr, nullptr, SS2, D};
        pg8::gemm_phase<pg8::EpiResid, pg8::StaticOrder, true, true>(lds, g, S, E);
    }
    grid.sync();

    {
        int lane6 = threadIdx.x & 63; asm volatile("" : "+v"(lane6));
        const float* gf = args.in[I_GFIN]; f32x4 gv[4];
#pragma unroll
        for (int j = 0; j < 4; ++j) gv[j] = *((const f32x4*)gf + lane6 + 64 * j);
        for (int m = gw; m < M; m += NGW) {
            const float p = (lane6 < 16) ? SS2[(size_t)m * 16 + lane6] : 0.f;
            const float rstd = 1.0f / sqrtf(wave_sum(p) * (1.0f / D) + EPS);
            f32x4* xr = (f32x4*)(out + (size_t)m * D) + lane6;
#pragma unroll
            for (int j = 0; j < 4; ++j) { const f32x4 v = xr[64 * j]; xr[64 * j] = v * rstd * gv[j]; }
        }
    }
}

extern "C" void kernel_launch(void* const* d_in, const int* in_sizes, int n_in, void* d_out, int out_size, void* d_ws, size_t ws_size, hipStream_t stream) {
    static int grid = 0;
    if (grid == 0) {
        if (n_in != 18 || in_sizes[0] != M * D || out_size != M * D || ws_size < WS_END) { fprintf(stderr, "kernel_launch: unexpected shapes (n_in %d, in0 %d, out %d, ws %zu); nothing launched\n", n_in, n_in > 0 ? in_sizes[0] : -1, out_size, ws_size); grid = -1; return; }
        int dev = 0, cus = 0, per_cu = 0;
        if (hipGetDevice(&dev) != hipSuccess || hipDeviceGetAttribute(&cus, hipDeviceAttributeMultiprocessorCount, dev) != hipSuccess) { grid = -1; return; }
        if (hipFuncSetAttribute((const void*)hybrid_fwd, hipFuncAttributeMaxDynamicSharedMemorySize, LDS_BYTES) != hipSuccess) { fprintf(stderr, "kernel_launch: hipFuncSetAttribute failed\n"); grid = -1; return; }
        if (hipOccupancyMaxActiveBlocksPerMultiprocessor(&per_cu, (const void*)hybrid_fwd, NWAVES * 64, LDS_BYTES) != hipSuccess || per_cu < 1) { fprintf(stderr, "kernel_launch: occupancy query says %d blocks per CU\n", per_cu); (void)hipGetLastError(); grid = -1; return; }
        grid = cus;
    }
    if (grid < 0) return;
    Args a{};
    for (int i = 0; i < 18; ++i) a.in[i] = (const float*)d_in[i];
    a.out = (float*)d_out; a.ws = (unsigned char*)d_ws;
    void* kargs[] = {&a};
    const hipError_t e = hipLaunchCooperativeKernel((const void*)hybrid_fwd, dim3(grid), dim3(NWAVES * 64), kargs, LDS_BYTES, stream);
    if (e != hipSuccess) fprintf(stderr, "kernel_launch: cooperative launch failed: %s (grid %d)\n", hipGetErrorString(e), grid);
}
```

```cpp
#include <hip/hip_runtime.h>
#include <cstdio>
#include <cstdint>

__device__ __forceinline__ float xsum16(float v) { return v + __builtin_bit_cast(float, __builtin_amdgcn_ds_swizzle(__builtin_bit_cast(int, v), 0x401F)); }
__device__ __forceinline__ float xsum32(float v) { const unsigned u = __builtin_bit_cast(unsigned, v); const auto r = __builtin_amdgcn_permlane32_swap(u, u, false, false);
    return __builtin_bit_cast(float, (unsigned)r[0]) + __builtin_bit_cast(float, (unsigned)r[1]); }
template <int CTRL> __device__ __forceinline__ float dpp0f(float v) { return __builtin_bit_cast(float, __builtin_amdgcn_update_dpp(0, __builtin_bit_cast(int, v), CTRL, 0xf, 0xf, false)); }
__device__ __forceinline__ float wave_sum_all(float v) {
    v += dpp0f<0xB1>(v); v += dpp0f<0x4E>(v); v += dpp0f<0x141>(v); v += dpp0f<0x140>(v);
    return xsum32(xsum16(v));
}
namespace pg8 {
#define PG8_LAS __attribute__((address_space(3)))
typedef unsigned short bf16_t;
typedef short bf16x8 __attribute__((ext_vector_type(8)));
typedef float f32x4 __attribute__((ext_vector_type(4)));
typedef unsigned u32x4 __attribute__((ext_vector_type(4)));
constexpr int BM = 256, BK = 64, HALF = 128, HTB = HALF * BK * 2  , STAGE_BYTES = 8 * HTB, NXCD = 8, WGM = 8;

__host__ __device__ __forceinline__ int lds_byte(int r, int c) { const int st = (r >> 4) * 2 + (c >> 5), rr = r & 15, cc = c & 31, ob = rr * 64 + cc * 2; return st * 1024 + (ob ^ (((ob >> 9) & 1) << 5)); }
__host__ __device__ __forceinline__ void stage_rc(int b, int& R, int& C) { const int st = b / 1024, sb = b % 1024, swz = sb ^ (((sb >> 9) & 1) << 5); R = (st >> 1) * 16 + swz / 64; C = (st & 1) * 32 + (swz % 64) / 2; }
__host__ __device__ __forceinline__ int perm32(int rho) { const int n = rho >> 4, i = rho & 15; return 8 * (i >> 2) + 4 * n + (i & 3); }

struct Unit { int pm, pn; };
struct Gemm { const bf16_t* A; const bf16_t* Bt; int M, N, K; };

struct StaticOrder {
    int nM, nN, nwg, G, c;
    __host__ __device__ void init(int M, int N, int G_, int c_) { nM = M / BM; nN = N / BM; nwg = nM * nN; G = G_; c = c_; }
    __host__ __device__ bool next(int i, Unit& u) const {
        const long L = (long)i * G + c; if (L >= nwg) return false;
        int wgid = (int)L; { const int q = nwg / NXCD, r = nwg % NXCD, xcd = wgid % NXCD, off = wgid / NXCD; wgid = (xcd < r ? xcd * (q + 1) : r * (q + 1) + (xcd - r) * q) + off; }
        const int nig = WGM * nN, gid = wgid / nig, fm = gid * WGM, gsz = (nM - fm) < WGM ? (nM - fm) : WGM;
        u.pm = fm + ((wgid % nig) % gsz); u.pn = (wgid % nig) / gsz; return true;
    }
    __device__ __forceinline__ void a_ready(const Unit&) const {}
    __device__ __forceinline__ void done(const Unit&) const {}
};

__device__ __forceinline__ unsigned cvt_pk_bf16(float lo, float hi) { unsigned r; asm volatile("v_cvt_pk_bf16_f32 %0, %1, %2" : "=v"(r) : "v"(lo), "v"(hi)); return r; }
typedef float f32x2 __attribute__((ext_vector_type(2)));
typedef unsigned u32x2 __attribute__((ext_vector_type(2)));
struct EpiStoreBf16 {
    static constexpr bool PERM = true, AFTER_DRAIN = false;
    bf16_t* O; int ldc;
    __device__ __forceinline__ void operator()(const f32x4 (&acc)[2][2][4][2], const Unit& u, int wr, int wc, int fr, int fq) const {
        const int row0 = u.pm * BM + wr * 64 + fr; const int col0 = u.pn * BM + wc * 32 + 8 * fq;
#pragma unroll
        for (int ai = 0; ai < 2; ++ai)
#pragma unroll
            for (int m = 0; m < 4; ++m) { bf16_t* rowp = O + (size_t)(row0 + ai * HALF + m * 16) * ldc + col0;
#pragma unroll
                for (int bj = 0; bj < 2; ++bj) { const f32x4 v0 = acc[ai][bj][m][0], v1 = acc[ai][bj][m][1];
                    u32x4 w; w.x = cvt_pk_bf16(v0[0], v0[1]); w.y = cvt_pk_bf16(v0[2], v0[3]); w.z = cvt_pk_bf16(v1[0], v1[1]); w.w = cvt_pk_bf16(v1[2], v1[3]);
                    *(u32x4*)(rowp + bj * HALF) = w; } }
    }
};
struct EpiRelu2 {
    static constexpr bool PERM = true, AFTER_DRAIN = false;
    bf16_t* O; int ldc; const float* ss; float inv_n, eps;
    __device__ __forceinline__ void operator()(const f32x4 (&acc)[2][2][4][2], const Unit& u, int wr, int wc, int fr, int fq) const {
        const int row0 = u.pm * BM + wr * 64 + fr; const int col0 = u.pn * BM + wc * 32 + 8 * fq;
#pragma unroll
        for (int ai = 0; ai < 2; ++ai)
#pragma unroll
            for (int m = 0; m < 4; ++m) { const int row = row0 + ai * HALF + m * 16;
                const f32x4 p = *(const f32x4*)(ss + (size_t)row * 16 + 4 * fq);
                float s = (p[0] + p[1]) + (p[2] + p[3]); s = xsum32(xsum16(s));
                const float rstd = 1.0f / sqrtf(s * inv_n + eps);
                bf16_t* rowp = O + (size_t)row * ldc + col0;
#pragma unroll
                for (int bj = 0; bj < 2; ++bj) { f32x4 v0 = acc[ai][bj][m][0] * rstd, v1 = acc[ai][bj][m][1] * rstd;
#pragma unroll
                    for (int e = 0; e < 4; ++e) { const float a0 = fmaxf(v0[e], 0.f), a1 = fmaxf(v1[e], 0.f); v0[e] = a0 * a0; v1[e] = a1 * a1; }
                    u32x4 w; w.x = cvt_pk_bf16(v0[0], v0[1]); w.y = cvt_pk_bf16(v0[2], v0[3]); w.z = cvt_pk_bf16(v1[0], v1[1]); w.w = cvt_pk_bf16(v1[2], v1[3]);
                    *(u32x4*)(rowp + bj * HALF) = w; } }
    }
};
struct EpiResid {
    static constexpr bool PERM = false, AFTER_DRAIN = false;
    const float* base; float* out; bf16_t* xb; const f32x2* rs; float* ss; int ldc;
    __device__ __forceinline__ void rescale(f32x4 (&acc)[2][2][4][2], const Unit& u, int wr, int fr) const {
#pragma unroll
        for (int ai = 0; ai < 2; ++ai)
#pragma unroll
            for (int m = 0; m < 4; ++m) { const int row = u.pm * BM + ai * HALF + wr * 64 + m * 16 + fr; const float f = rs[row].x;
#pragma unroll
                for (int bj = 0; bj < 2; ++bj)
#pragma unroll
                    for (int n = 0; n < 2; ++n) acc[ai][bj][m][n] = acc[ai][bj][m][n] * f; }
    }
    __device__ __forceinline__ void operator()(const f32x4 (&acc)[2][2][4][2], const Unit& u, int wr, int wc, int fr, int fq) const {
        const int col0 = u.pn * BM + wc * 32 + 4 * fq;
#pragma unroll
        for (int ai = 0; ai < 2; ++ai)
#pragma unroll
            for (int m = 0; m < 4; ++m) { const int row = u.pm * BM + ai * HALF + wr * 64 + m * 16 + fr; const size_t off = (size_t)row * ldc + col0;
                const float sc = rs ? rs[row].y : 1.0f; float q = 0.f;
#pragma unroll
                for (int bj = 0; bj < 2; ++bj)
#pragma unroll
                    for (int n = 0; n < 2; ++n) { const f32x4 bs = *(const f32x4*)(base + off + bj * HALF + n * 16); const f32x4 o = bs + acc[ai][bj][m][n] * sc;
                        *(f32x4*)(out + off + bj * HALF + n * 16) = o; q += (o[0] * o[0] + o[1] * o[1]) + (o[2] * o[2] + o[3] * o[3]);
                        if (xb) { u32x2 w; w.x = cvt_pk_bf16(o[0], o[1]); w.y = cvt_pk_bf16(o[2], o[3]); *(u32x2*)(xb + off + bj * HALF + n * 16) = w; } }
                q = xsum32(xsum16(q));
                if (fq == 0) ss[(size_t)row * 16 + 4 * u.pn + wc] = q;
                if (m & 1) asm volatile("" ::: "memory"); }
    }
};
template <class Epi, class Sched, bool ALIGN_EPI = false, bool SP2 = false, int RST = -1>
__device__ __forceinline__ void gemm_phase(PG8_LAS unsigned char* lds, const Gemm g, const Sched& S, const Epi& E) {
    int tid_ = __builtin_amdgcn_readfirstlane(threadIdx.x >> 6) * 64 + (int)__lane_id(); asm volatile("" : "+v"(tid_));
    const int tid = tid_, wid = __builtin_amdgcn_readfirstlane(tid >> 6), lane = tid & 63, wr = wid >> 2, wc = wid & 3, fr = lane & 15, fq = lane >> 4;
    const int K = g.K, nt = K / BK;
    unsigned voffA[2], voffB[2];
#pragma unroll
    for (int i = 0; i < 2; ++i) { int R, C; stage_rc(tid * 16 + i * 8192, R, C); const int Rb = Epi::PERM ? ((R & ~31) + perm32(R & 31)) : R;
        voffA[i] = (unsigned)(R * K + C) * 2u; voffB[i] = (unsigned)(Rb * K + C) * 2u; }
    const size_t kstep = (size_t)(BK * 2);
    const size_t hstep = (size_t)HALF * K * 2;
    const size_t tstep = 2 * hstep;
    const unsigned ldsw = (unsigned)wid * 1024u;
    const int aoff = lds_byte(wr * 64 + fr, fq * 8), boff = lds_byte(wc * 32 + fr, fq * 8);
#define PG8_SA(b, h) (((b) * 2 + (h)) * HTB)
#define PG8_SB(b, h) ((4 + (b) * 2 + (h)) * HTB)
#define PG8_STAGE(bufoff, gbase, voff) do { _Pragma("unroll") for (int _i = 0; _i < 2; ++_i) \
        __builtin_amdgcn_global_load_lds((const unsigned*)((const char*)(gbase) + (voff)[_i]), (PG8_LAS unsigned*)(lds + (bufoff) + ldsw + _i * 8192), 16, 0, 0); } while (0)
#define PG8_LDA(dst, b, h) do { _Pragma("unroll") for (int m = 0; m < 4; ++m) _Pragma("unroll") for (int k = 0; k < 2; ++k) dst[m][k] = *(const PG8_LAS bf16x8*)(lds + PG8_SA(b, h) + aoff + m * 2048 + k * 1024); } while (0)
#define PG8_LDB(dst, b, h) do { _Pragma("unroll") for (int n = 0; n < 2; ++n) _Pragma("unroll") for (int k = 0; k < 2; ++k) dst[n][k] = *(const PG8_LAS bf16x8*)(lds + PG8_SB(b, h) + boff + n * 2048 + k * 1024); } while (0)
#define PG8_MMA(ai, bj, At, Bt) do { __builtin_amdgcn_s_setprio(1); _Pragma("unroll") for (int m = 0; m < 4; ++m) _Pragma("unroll") for (int n = 0; n < 2; ++n) _Pragma("unroll") for (int k = 0; k < 2; ++k) \
        acc[ai][bj][m][n] = __builtin_amdgcn_mfma_f32_16x16x32_bf16(Bt[n][k], At[m][k], acc[ai][bj][m][n], 0, 0, 0); __builtin_amdgcn_s_setprio(0); } while (0)
#define PG8_WAIT_V(n) asm volatile("s_waitcnt vmcnt(" #n ")" ::: "memory")
#define PG8_WAIT_L(n) asm volatile("s_waitcnt lgkmcnt(" #n ")" ::: "memory")
#define PG8_BAR __builtin_amdgcn_s_barrier()
#define PG8_SCHED __builtin_amdgcn_sched_barrier(0)
    Unit cur, nxt; int ui = 0;
    if (!S.next(0, cur)) return;
    f32x4 acc[2][2][4][2];
#pragma unroll
    for (int a = 0; a < 2; ++a)
#pragma unroll
        for (int b = 0; b < 2; ++b)
#pragma unroll
            for (int m = 0; m < 4; ++m)
#pragma unroll
                for (int n = 0; n < 2; ++n) acc[a][b][m][n] = (f32x4){0.f, 0.f, 0.f, 0.f};
    bf16x8 At[4][2], B0[2][2], B1[2][2];
    const char* cA = (const char*)g.A + (size_t)cur.pm * tstep; const char* cB = (const char*)g.Bt + (size_t)cur.pn * tstep;
    S.a_ready(cur);
    if constexpr (SP2) {
        PG8_STAGE(PG8_SB(0, 0), cB, voffB); PG8_STAGE(PG8_SB(0, 1), cB + hstep, voffB); PG8_STAGE(PG8_SA(0, 0), cA, voffA); PG8_STAGE(PG8_SA(0, 1), cA + hstep, voffA);
        if (wr == 1) PG8_BAR;
        PG8_WAIT_V(2); PG8_BAR;
        PG8_STAGE(PG8_SB(1, 0), cB + kstep, voffB); PG8_STAGE(PG8_SA(1, 0), cA + kstep, voffA); PG8_STAGE(PG8_SB(1, 1), cB + hstep + kstep, voffB);
        PG8_WAIT_V(6); PG8_BAR;
    } else {
        PG8_STAGE(PG8_SB(0, 0), cB, voffB); PG8_STAGE(PG8_SA(0, 0), cA, voffA); PG8_STAGE(PG8_SB(0, 1), cB + hstep, voffB); PG8_STAGE(PG8_SA(0, 1), cA + hstep, voffA);
        if (wr == 1) PG8_BAR;
        PG8_WAIT_V(4); PG8_BAR;
        PG8_STAGE(PG8_SB(1, 0), cB + kstep, voffB); PG8_STAGE(PG8_SA(1, 0), cA + kstep, voffA); PG8_STAGE(PG8_SB(1, 1), cB + hstep + kstep, voffB);
        PG8_WAIT_V(6); PG8_BAR;
    }
    for (;;) {
        const bool has_next = S.next(ui + 1, nxt);
        const char* nA = has_next ? (const char*)g.A + (size_t)nxt.pm * tstep : cA; const char* nB = has_next ? (const char*)g.Bt + (size_t)nxt.pn * tstep : cB;
        for (int t = 0; t < nt; t += 2) {
            const bool last = (t == nt - 2);
            if constexpr (RST >= 0) { if (t == RST) E.rescale(acc, cur, wr, fr); }
            const char* a1 = cA + (size_t)(t + 1) * kstep;
            const char* a2 = last ? nA : cA + (size_t)(t + 2) * kstep; const char* b2 = last ? nB : cB + (size_t)(t + 2) * kstep;
            const char* a3 = a2 + kstep; const char* b3 = b2 + kstep;
            if (last && has_next) S.a_ready(nxt);
            if constexpr (SP2) {
            PG8_LDB(B0, 0, 0); PG8_LDB(B1, 0, 1); PG8_SCHED; PG8_LDA(At, 0, 0); PG8_STAGE(PG8_SA(1, 1), a1 + hstep, voffA);
            PG8_WAIT_V(8); PG8_WAIT_L(0); PG8_BAR; PG8_MMA(0, 0, At, B0); PG8_MMA(0, 1, At, B1); PG8_BAR; PG8_SCHED;
            PG8_LDA(At, 0, 1); PG8_STAGE(PG8_SB(0, 0), b2, voffB); PG8_STAGE(PG8_SB(0, 1), b2 + hstep, voffB); PG8_STAGE(PG8_SA(0, 0), a2, voffA);
            PG8_WAIT_V(8); PG8_WAIT_L(0); PG8_BAR; PG8_MMA(1, 0, At, B0); PG8_MMA(1, 1, At, B1); PG8_BAR; PG8_SCHED;
            PG8_LDB(B0, 1, 0); PG8_LDB(B1, 1, 1); PG8_SCHED; PG8_LDA(At, 1, 0); PG8_STAGE(PG8_SA(0, 1), a2 + hstep, voffA);
            PG8_WAIT_V(8); PG8_WAIT_L(0); PG8_BAR; PG8_MMA(0, 0, At, B0); PG8_MMA(0, 1, At, B1); PG8_BAR; PG8_SCHED;
            PG8_LDA(At, 1, 1); PG8_STAGE(PG8_SB(1, 0), b3, voffB); PG8_STAGE(PG8_SB(1, 1), b3 + hstep, voffB); PG8_STAGE(PG8_SA(1, 0), a3, voffA);
            PG8_WAIT_V(8); PG8_WAIT_L(0); PG8_BAR; PG8_MMA(1, 0, At, B0); PG8_MMA(1, 1, At, B1); PG8_BAR; PG8_SCHED;
            } else {
            PG8_LDB(B0, 0, 0); PG8_SCHED; PG8_LDA(At, 0, 0); PG8_STAGE(PG8_SA(1, 1), a1 + hstep, voffA);
            PG8_WAIT_L(8); PG8_BAR; PG8_WAIT_L(0); PG8_MMA(0, 0, At, B0); PG8_BAR; PG8_SCHED;
            PG8_LDB(B1, 0, 1); PG8_STAGE(PG8_SB(0, 0), b2, voffB);
            PG8_BAR; PG8_WAIT_L(0); PG8_MMA(0, 1, At, B1); PG8_BAR;
            PG8_LDA(At, 0, 1); PG8_STAGE(PG8_SA(0, 0), a2, voffA);
            PG8_BAR; PG8_WAIT_L(0); PG8_MMA(1, 0, At, B0); PG8_BAR; PG8_SCHED;
            PG8_STAGE(PG8_SB(0, 1), b2 + hstep, voffB);
            PG8_WAIT_V(6); PG8_BAR; PG8_MMA(1, 1, At, B1); PG8_BAR;
            PG8_LDB(B0, 1, 0); PG8_SCHED; PG8_LDA(At, 1, 0); PG8_STAGE(PG8_SA(0, 1), a2 + hstep, voffA);
            PG8_WAIT_L(8); PG8_BAR; PG8_WAIT_L(0); PG8_MMA(0, 0, At, B0); PG8_BAR; PG8_SCHED;
            PG8_LDB(B1, 1, 1); PG8_STAGE(PG8_SB(1, 0), b3, voffB);
            PG8_BAR; PG8_WAIT_L(0); PG8_MMA(0, 1, At, B1); PG8_BAR;
            PG8_LDA(At, 1, 1); PG8_STAGE(PG8_SA(1, 0), a3, voffA);
            PG8_BAR; PG8_WAIT_L(0); PG8_MMA(1, 0, At, B0); PG8_BAR; PG8_SCHED;
            PG8_STAGE(PG8_SB(1, 1), b3 + hstep, voffB);
            PG8_WAIT_V(6); PG8_BAR; PG8_MMA(1, 1, At, B1); PG8_BAR;
            }
        }
        if constexpr (ALIGN_EPI) { if (wr == 0) PG8_BAR; }
        if constexpr (!Epi::AFTER_DRAIN) { E(acc, cur, wr, wc, fr, fq); S.done(cur); }
        if (!has_next) break;
#pragma unroll
        for (int a = 0; a < 2; ++a)
#pragma unroll
            for (int b = 0; b < 2; ++b)
#pragma unroll
                for (int m = 0; m < 4; ++m)
#pragma unroll
                    for (int n = 0; n < 2; ++n) acc[a][b][m][n] = (f32x4){0.f, 0.f, 0.f, 0.f};
        cur = nxt; cA = nA; cB = nB; ++ui;
        if constexpr (ALIGN_EPI) { if (wr == 1) PG8_BAR; }
    }
    PG8_WAIT_V(0);
    if constexpr (!ALIGN_EPI) { if (wr == 0) PG8_BAR; }
    PG8_BAR;
    if constexpr (Epi::AFTER_DRAIN) { E.fused(acc, cur, wr, wc, fr, fq, lds, wid, lane); S.done(cur); }
#undef PG8_SA
#undef PG8_SB
#undef PG8_STAGE
#undef PG8_LDA
#undef PG8_LDB
#undef PG8_MMA
#undef PG8_WAIT_V
#undef PG8_WAIT_L
#undef PG8_BAR
#undef PG8_SCHED
}
}
constexpr int NWAVES = 8;
constexpr int BATCH = 8, SEQ = 4096, D = 1024, CW = 512, LW = 1024, MIXW = CW + LW, INC = 3 * CW + 2 * LW, FF = 4096, NH = 16;
constexpr int M = BATCH * SEQ;
constexpr int COL_GB = 0, COL_GC = CW, COL_V = 2 * CW, COL_XR = 3 * CW, COL_G = 3 * CW + LW;
constexpr float EPS = 1e-6f;
constexpr int TCH = 128, NCHUNK = SEQ / TCH;
constexpr size_t MiB = 1u << 20;
constexpr int CW_BAR = 4096; constexpr size_t CTL_ZERO_BYTES = 64 * 1024;
constexpr size_t WS_WIN = 2 * MiB, WS_WOUT = 10 * MiB, WS_W1 = 14 * MiB, WS_W2 = 22 * MiB;
constexpr size_t WS_WF = 30 * MiB;
constexpr size_t WS_NSP = 30 * MiB + 512 * 1024;
constexpr size_t WS_SUMA = 31 * MiB, WS_SUMH = 32 * MiB;
constexpr size_t WS_RS = 33 * MiB;
constexpr size_t WS_SS1 = 34 * MiB, WS_SS2 = 36 * MiB;
constexpr size_t WS_XN = 40 * MiB;
constexpr size_t WS_U = 104 * MiB;
constexpr size_t WS_Y = 328 * MiB;
constexpr size_t WS_Z = 104 * MiB;
constexpr size_t WS_END = 424 * MiB;
static_assert(WS_XN + (size_t)M * D * 2 <= WS_U && WS_U + (size_t)M * INC * 2 <= WS_Y && WS_Y + (size_t)M * MIXW * 2 <= WS_END && WS_Z + (size_t)M * FF * 2 <= WS_END, "d_ws map");
static_assert(WS_WIN + (size_t)INC * D * 2 <= WS_WOUT && WS_WOUT + (size_t)D * MIXW * 2 <= WS_W1 && WS_W1 + (size_t)FF * D * 2 <= WS_W2 && WS_W2 + (size_t)FF * D * 2 <= WS_WF, "weights map");
constexpr int RING_BYTES = 131072;
constexpr int LDS_BYTES = 147456;
constexpr int L_RCW = 0, L_RCB = 16384, L_BA = 20480, L_BX = 24576, L_NSP = 28672, L_CW = 32768, L_SSA = 38912, L_SSB = 43008, L_MIX_END = 51200;

#define LAS __attribute__((address_space(3)))
typedef unsigned short bf16;
typedef unsigned v4u __attribute__((ext_vector_type(4)));
typedef float f32x4 __attribute__((ext_vector_type(4)));
typedef float f32x2 __attribute__((ext_vector_type(2)));
typedef short bf16x8 __attribute__((ext_vector_type(8)));
#define LDS_WAIT() asm volatile("s_waitcnt lgkmcnt(0)" ::: "memory")
__device__ __forceinline__ unsigned pk2(float lo, float hi) { return pg8::cvt_pk_bf16(lo, hi); }
__device__ __forceinline__ float bf_lo(unsigned u) { return __builtin_bit_cast(float, u << 16); }
__device__ __forceinline__ float bf_hi(unsigned u) { return __builtin_bit_cast(float, u & 0xffff0000u); }
__device__ __forceinline__ float wave_sum(float v) { return wave_sum_all(v); }
__device__ __forceinline__ int my_tid() { return __builtin_amdgcn_readfirstlane(threadIdx.x >> 6) * 64 + (int)__lane_id(); }
template <int CTRL> __device__ __forceinline__ float dppf(float oldv, float v) {
    return __builtin_bit_cast(float, __builtin_amdgcn_update_dpp(__builtin_bit_cast(int, oldv), __builtin_bit_cast(int, v), CTRL, 0xf, 0xf, false));
}
__device__ __forceinline__ float sigm(float x) { return __builtin_amdgcn_rcpf(1.0f + __expf(-x)); }

typedef __attribute__((address_space(1))) unsigned gu32;
#define XB_TMO      128
#define XB_XCNT(j)  (256  + 64 * (j))
#define XB_XSUB(j)  (1280 + 64 * (j))
#define XB_XGEN(j)  (2304 + 64 * (j))
#define XB_TOP      3328
#define XB_TOPGEN   3392
#define XCD_BAR_WORDS 3456
#define XB_SPIN_CAP (1u << 18)

__device__ __forceinline__ unsigned xb_ld(unsigned* p)              { return __hip_atomic_load(p, __ATOMIC_RELAXED, __HIP_MEMORY_SCOPE_AGENT); }
__device__ __forceinline__ unsigned xb_add(unsigned* p, unsigned v) { return __hip_atomic_fetch_add(p, v, __ATOMIC_RELAXED, __HIP_MEMORY_SCOPE_AGENT); }
__device__ __forceinline__ unsigned xb_xcc_id() { return (unsigned)__builtin_amdgcn_s_getreg((3 << 11) | 20) & 0xFu; }
#define XB_SPIN(cond, bar) do { unsigned _sp = 0; while (cond) { __builtin_amdgcn_s_sleep(1); \
    if ((++_sp & 255u) == 0u) { if (xb_ld(&(bar)[XB_TMO])) break; if (_sp > XB_SPIN_CAP) { atomicAdd(&(bar)[XB_TMO], 1u); break; } } } } while (0)

struct XcdBarrier {
    unsigned* bar; unsigned x;
    volatile LAS unsigned* st;
};

__device__ __forceinline__ XcdBarrier xcd_barrier_post(unsigned* bar, volatile LAS unsigned* st) {
    XcdBarrier b; b.bar = bar; b.x = xb_xcc_id(); b.st = st;
    if (my_tid() == 0) (void)xb_add(&bar[XB_XCNT(b.x)], 1u);
    return b;
}
__device__ __forceinline__ void xcd_barrier_complete(unsigned* bar, unsigned x, unsigned& nloc, unsigned& nx) {
    const unsigned G = gridDim.x * gridDim.y * gridDim.z;
    unsigned sum, cnt, mine, sp = 0u;
    for (;;) {
        sum = 0u; cnt = 0u; mine = 0u;
#pragma unroll
        for (unsigned j = 0; j < 16; ++j) { const unsigned c = xb_ld(&bar[XB_XCNT(j)]); sum += c; cnt += (c > 0u) ? 1u : 0u; mine = (j == x) ? c : mine; }
        if (sum == G) break;
        __builtin_amdgcn_s_sleep(1);
        if ((++sp & 255u) == 0u) { if (xb_ld(&bar[XB_TMO])) break; if (sp > XB_SPIN_CAP) { atomicAdd(&bar[XB_TMO], 1u); break; } }
    }
    nloc = mine > 0u ? mine : 1u; nx = cnt > 0u ? cnt : 1u;
}

__device__ __forceinline__ void xcd_barrier(const XcdBarrier& b) {
    asm volatile("s_waitcnt vmcnt(0)" ::: "memory");
    __syncthreads();
    if (my_tid() == 0) {
        unsigned* bar = b.bar;
        __builtin_amdgcn_s_waitcnt(0);
        unsigned nloc = b.st[0], nx = b.st[1];
        if (nloc == 0u) { xcd_barrier_complete(bar, b.x, nloc, nx); b.st[0] = nloc; b.st[1] = nx; }
        const unsigned old = xb_add(&bar[XB_XSUB(b.x)], 1u);
        const unsigned gen = old / nloc;
        if (old + 1u == (gen + 1u) * nloc) {
            __builtin_amdgcn_fence(__ATOMIC_RELEASE, "agent");
            asm volatile("s_waitcnt vmcnt(0)" ::: "memory");
            const unsigned og = xb_add(&bar[XB_TOP], 1u);
            const unsigned tg = og / nx;
            if (og + 1u == (tg + 1u) * nx) xb_add(&bar[XB_TOPGEN], 1u);
            else XB_SPIN(xb_ld(&bar[XB_TOPGEN]) == tg, bar);
            __builtin_amdgcn_fence(__ATOMIC_ACQUIRE, "agent");
            xb_add(&bar[XB_XGEN(b.x)], 1u);
            asm volatile("s_waitcnt vmcnt(0)" ::: "memory");
        } else {
            XB_SPIN(xb_ld(&bar[XB_XGEN(b.x)]) == gen, bar);
            __builtin_amdgcn_fence(__ATOMIC_ACQUIRE, "agent");
            asm volatile("s_waitcnt vmcnt(0)" ::: "memory");
        }
    }
    __syncthreads();
}

struct Args { const float* in[18]; float* out; unsigned char* ws; };
enum { I_X = 0, I_GMIX, I_WIN, I_CONVW, I_RCW, I_RCB, I_WA, I_BA, I_WX, I_BX, I_LAM, I_GCONV, I_GRNN, I_WOUT, I_GMLP, I_W1, I_W2, I_GFIN };

__device__ __forceinline__ void p0_transpose_item(const float* W, int K, int N, bf16* WT, LAS float* scr, int item, int lane, const float* g0, const float* g1, int split) {
    const int nblk = N / 32, kb = item / nblk, nb = item % nblk, k0 = 64 * kb, n0 = 32 * nb;
#pragma unroll 8
    for (int i = 0; i < 32; ++i) { const int kk = 2 * i + (lane >> 5); const int k = k0 + kk;
        const float gn = g0 ? (k < split ? g0[k] : g1[k - split]) : 1.0f;
        scr[kk * 33 + (lane & 31)] = W[(size_t)k * N + n0 + (lane & 31)] * gn; }
    LDS_WAIT(); asm volatile("" ::: "memory");
    const int c = lane & 7;
#pragma unroll
    for (int j = 0; j < 4; ++j) { const int n = (lane >> 3) + 8 * j; const LAS float* s = scr + (8 * c) * 33 + n;
        v4u o; o.x = pk2(s[0 * 33], s[1 * 33]); o.y = pk2(s[2 * 33], s[3 * 33]); o.z = pk2(s[4 * 33], s[5 * 33]); o.w = pk2(s[6 * 33], s[7 * 33]);
        *(v4u*)(WT + (size_t)(n0 + n) * K + k0 + 8 * c) = o; }
    LDS_WAIT(); asm volatile("" ::: "memory");
}

struct MixP { const bf16* U; const bf16* WF; bf16* Y; float* SUMA; float* SUMH; f32x2* RS; };

template <int CTRL> __device__ __forceinline__ unsigned dppu(unsigned oldv, unsigned v) { return (unsigned)__builtin_amdgcn_update_dpp((int)oldv, (int)v, CTRL, 0xf, 0xf, false); }
#define SHIFT_U(SH, cur, prev) dppu<0x110 + SH>(dppu<0x120 + SH>(0u, (prev)), (cur))
#define SHIFT_F(SH, cur, prev) dppf<0x110 + SH>(dppf<0x120 + SH>(0.f, (prev)), (cur))
#define DPP_COMBINE(CTRL, Bv, Av) { const float Bs_ = dppf<CTRL>(0.f, Bv), As_ = dppf<CTRL>(1.f, Av); Bv = fmaf(Av, Bs_, Bv); Av *= As_; }
__device__ __forceinline__ void ld2(v4u (&d)[2], const bf16* p) { const v4u* s = (const v4u*)p; d[0] = s[0]; d[1] = s[1]; }

template <int PASS>
__device__ __forceinline__ void lru_tile(LAS unsigned char* lds, const v4u (&xc)[2], const v4u (&xp)[2], const v4u (&gg)[2], const bf16x8 (&WA)[4][2], const bf16x8 (&WX)[4][2], float (&hc)[16], float (&ac)[16],
                                         bf16* yrow, int ch0, int fr, int fq, int tok, int h) {
    const unsigned cw[8] = {xc[0].x, xc[0].y, xc[0].z, xc[0].w, xc[1].x, xc[1].y, xc[1].z, xc[1].w};
    const unsigned pw[8] = {xp[0].x, xp[0].y, xp[0].z, xp[0].w, xp[1].x, xp[1].y, xp[1].z, xp[1].w};
    float xr[16];
#pragma unroll
    for (int q = 0; q < 4; ++q) {
        const f32x4 bs = *(const LAS f32x4*)(lds + L_RCB + (ch0 + 4 * q) * 4);
        const f32x4 w0 = *(const LAS f32x4*)(lds + L_RCW + (0 * LW + ch0 + 4 * q) * 4), w1 = *(const LAS f32x4*)(lds + L_RCW + (1 * LW + ch0 + 4 * q) * 4),
                    w2 = *(const LAS f32x4*)(lds + L_RCW + (2 * LW + ch0 + 4 * q) * 4), w3 = *(const LAS f32x4*)(lds + L_RCW + (3 * LW + ch0 + 4 * q) * 4);
#pragma unroll
        for (int e = 0; e < 2; ++e) { const unsigned c_ = cw[2 * q + e], p_ = pw[2 * q + e];
            const unsigned s1 = SHIFT_U(1, c_, p_), s2 = SHIFT_U(2, c_, p_), s3 = SHIFT_U(3, c_, p_);
            xr[4 * q + 2 * e]     = fmaf(w3[2 * e], bf_lo(c_), fmaf(w2[2 * e], bf_lo(s1), fmaf(w1[2 * e], bf_lo(s2), fmaf(w0[2 * e], bf_lo(s3), bs[2 * e]))));
            xr[4 * q + 2 * e + 1] = fmaf(w3[2 * e + 1], bf_hi(c_), fmaf(w2[2 * e + 1], bf_hi(s1), fmaf(w1[2 * e + 1], bf_hi(s2), fmaf(w0[2 * e + 1], bf_hi(s3), bs[2 * e + 1])))); }
    }
    v4u xb0, xb1;
    xb0.x = pk2(xr[0], xr[1]); xb0.y = pk2(xr[2], xr[3]); xb0.z = pk2(xr[4], xr[5]); xb0.w = pk2(xr[6], xr[7]);
    xb1.x = pk2(xr[8], xr[9]); xb1.y = pk2(xr[10], xr[11]); xb1.z = pk2(xr[12], xr[13]); xb1.w = pk2(xr[14], xr[15]);
    const bf16x8 X0 = __builtin_bit_cast(bf16x8, xb0), X1 = __builtin_bit_cast(bf16x8, xb1);
    const unsigned gwd[8] = {gg[0].x, gg[0].y, gg[0].z, gg[0].w, gg[1].x, gg[1].y, gg[1].z, gg[1].w};
    unsigned yo[8]; float q2 = 0.f;
#pragma unroll
    for (int n = 0; n < 4; ++n) {
        f32x4 aA = (f32x4){0.f, 0.f, 0.f, 0.f}, aX = (f32x4){0.f, 0.f, 0.f, 0.f};
        aA = __builtin_amdgcn_mfma_f32_16x16x32_bf16(WA[n][0], X0, aA, 0, 0, 0); aA = __builtin_amdgcn_mfma_f32_16x16x32_bf16(WA[n][1], X1, aA, 0, 0, 0);
        aX = __builtin_amdgcn_mfma_f32_16x16x32_bf16(WX[n][0], X0, aX, 0, 0, 0); aX = __builtin_amdgcn_mfma_f32_16x16x32_bf16(WX[n][1], X1, aX, 0, 0, 0);
        const f32x4 ba4 = *(const LAS f32x4*)(lds + L_BA + (ch0 + 4 * n) * 4), bx4 = *(const LAS f32x4*)(lds + L_BX + (ch0 + 4 * n) * 4), ns4 = *(const LAS f32x4*)(lds + L_NSP + (ch0 + 4 * n) * 4);
        float yv4[4];
#pragma unroll
        for (int j = 0; j < 4; ++j) {
            const int i = 4 * n + j;
            const float r = sigm(aA[j] + ba4[j]), ig = sigm(aX[j] + bx4[j]);
            const float la = ns4[j] * r; const float av = __expf(la);
            const float mult = __builtin_amdgcn_sqrtf(fmaf(-av, av, 1.0f));
            float bv = mult * ig * xr[i];
            const float hp = dppf<0x121>(0.f, hc[i]);
            bv = (fr == 0) ? fmaf(av, hp, bv) : bv;
            float A = av;
            if (PASS == 0) { const float ap = dppf<0x121>(1.f, ac[i]); A = (fr == 0) ? av * ap : av; }
            DPP_COMBINE(0x111, bv, A) DPP_COMBINE(0x112, bv, A) DPP_COMBINE(0x114, bv, A) DPP_COMBINE(0x118, bv, A)
            hc[i] = bv; if (PASS == 0) ac[i] = A;
            if (PASS == 1) {
                const unsigned gw_ = gwd[i >> 1];
                const float g = (i & 1) ? bf_hi(gw_) : bf_lo(gw_);
                const float u3 = 1.5957691216f * (g + 0.044715f * g * g * g);
                const float yv = bv * (g * sigm(u3));
                yv4[j] = yv; q2 = fmaf(yv, yv, q2);
            }
        }
        if (PASS == 1) { yo[2 * n] = pk2(yv4[0], yv4[1]); yo[2 * n + 1] = pk2(yv4[2], yv4[3]); }
    }
    if (PASS == 1) {
        v4u* dst = (v4u*)yrow; dst[0] = (v4u){yo[0], yo[1], yo[2], yo[3]}; dst[1] = (v4u){yo[4], yo[5], yo[6], yo[7]};
        q2 = xsum32(xsum16(q2));
        if (fq == 0) ((LAS float*)(lds + L_SSB))[tok * 16 + h] = q2;
    }
}

__device__ __forceinline__ void conv_tile(LAS unsigned char* lds, const v4u (&gc)[2], const v4u (&vv)[2], const v4u (&gb)[2], float (&pp)[16], bf16* yrow, int ca0, int fr, int fq, int tok, int wave) {
    const unsigned cwd[8] = {gc[0].x, gc[0].y, gc[0].z, gc[0].w, gc[1].x, gc[1].y, gc[1].z, gc[1].w};
    const unsigned vwd[8] = {vv[0].x, vv[0].y, vv[0].z, vv[0].w, vv[1].x, vv[1].y, vv[1].z, vv[1].w};
    const unsigned bwd[8] = {gb[0].x, gb[0].y, gb[0].z, gb[0].w, gb[1].x, gb[1].y, gb[1].z, gb[1].w};
    unsigned yo[8]; float q2 = 0.f;
#pragma unroll
    for (int q = 0; q < 4; ++q) {
        const f32x4 w0 = *(const LAS f32x4*)(lds + L_CW + (0 * CW + ca0 + 4 * q) * 4), w1 = *(const LAS f32x4*)(lds + L_CW + (1 * CW + ca0 + 4 * q) * 4), w2 = *(const LAS f32x4*)(lds + L_CW + (2 * CW + ca0 + 4 * q) * 4);
        float y4[4];
#pragma unroll
        for (int e = 0; e < 4; ++e) { const int i = 4 * q + e; const unsigned cwd_ = cwd[i >> 1], vwd_ = vwd[i >> 1], bwd_ = bwd[i >> 1];
            const float p = (i & 1) ? bf_hi(cwd_) * bf_hi(vwd_) : bf_lo(cwd_) * bf_lo(vwd_);
            const float s1 = SHIFT_F(1, p, pp[i]), s2 = SHIFT_F(2, p, pp[i]);
            pp[i] = p;
            const float yv = ((i & 1) ? bf_hi(bwd_) : bf_lo(bwd_)) * fmaf(w2[e], p, fmaf(w1[e], s1, w0[e] * s2));
            y4[e] = yv; q2 = fmaf(yv, yv, q2); }
        yo[2 * q] = pk2(y4[0], y4[1]); yo[2 * q + 1] = pk2(y4[2], y4[3]);
    }
    v4u* dst = (v4u*)yrow; dst[0] = (v4u){yo[0], yo[1], yo[2], yo[3]}; dst[1] = (v4u){yo[4], yo[5], yo[6], yo[7]};
    q2 = xsum32(xsum16(q2));
    if (fq == 0) ((LAS float*)(lds + L_SSA))[tok * 8 + wave] = q2;
}

template <int PASS>
__device__ __forceinline__ void mixer_unit(LAS unsigned char* lds, const MixP& P, int b, int c, int wave, int lane, int tid) {
    const size_t rowbase = (size_t)b * SEQ;
    const size_t row0 = rowbase + (size_t)c * TCH;
    const size_t prow0 = c > 0 ? row0 - 16 : row0;
    constexpr int NT = TCH / 16;
#pragma unroll 1
    for (int hl = 0; hl < 2; ++hl) {
        int lane_w = (int)__lane_id(); asm volatile("" : "+v"(lane_w));
        const int fr = lane_w & 15, fq = lane_w >> 4;
        const int h = wave * 2 + hl, ch0 = 64 * h + 16 * fq;
        const int loffU = fr * INC + 16 * fq, loffY = fr * MIXW + 16 * fq;
        float hc[16], ac[16];
#pragma unroll
        for (int i = 0; i < 16; ++i) { hc[i] = 0.f; ac[i] = 1.f; }
        if (PASS == 1) {
            const bool v0 = fr < c, v1 = (16 + fr) < c;
            const size_t o0 = ((size_t)(b * NCHUNK + (v0 ? fr : 0))) * LW + ch0, o1 = ((size_t)(b * NCHUNK + (v1 ? 16 + fr : 0))) * LW + ch0;
#pragma unroll
            for (int q = 0; q < 4; ++q) {
                const f32x4 a0 = *(const f32x4*)(P.SUMA + o0 + 4 * q), h0 = *(const f32x4*)(P.SUMH + o0 + 4 * q), a1 = *(const f32x4*)(P.SUMA + o1 + 4 * q), h1 = *(const f32x4*)(P.SUMH + o1 + 4 * q);
#pragma unroll
                for (int e = 0; e < 4; ++e) {
                    float a = v0 ? a0[e] : 1.f, hh = v0 ? h0[e] : 0.f, a2 = v1 ? a1[e] : 1.f, h2 = v1 ? h1[e] : 0.f;
                    DPP_COMBINE(0x111, hh, a) DPP_COMBINE(0x112, hh, a) DPP_COMBINE(0x114, hh, a) DPP_COMBINE(0x118, hh, a)
                    DPP_COMBINE(0x111, h2, a2) DPP_COMBINE(0x112, h2, a2) DPP_COMBINE(0x114, h2, a2) DPP_COMBINE(0x118, h2, a2)
                    hc[4 * q + e] = fmaf(a2, hh, h2);
                }
            }
            asm volatile("" ::: "memory");
        }
        bf16x8 WA[4][2], WX[4][2];
#pragma unroll
        for (int n = 0; n < 4; ++n)
#pragma unroll
            for (int s = 0; s < 2; ++s) {
                WA[n][s] = *(const bf16x8*)(P.WF + ((size_t)((((h * 2 + 0) * 4 + n) * 2 + s) * 64 + lane_w)) * 8);
                WX[n][s] = *(const bf16x8*)(P.WF + ((size_t)((((h * 2 + 1) * 4 + n) * 2 + s) * 64 + lane_w)) * 8); }
        v4u xp[2], xc[2], xn[2], gcur[2], gnx[2];
        ld2(xp, P.U + (prow0 * INC + COL_XR + 64 * h) + loffU);
        if (c == 0) { xp[0] = (v4u){0u, 0u, 0u, 0u}; xp[1] = xp[0]; }
        ld2(xc, P.U + (row0 * INC + COL_XR + 64 * h) + loffU);
        gcur[0] = (v4u){0u, 0u, 0u, 0u}; gcur[1] = gcur[0]; gnx[0] = gcur[0]; gnx[1] = gcur[0];
        if (PASS == 1) ld2(gcur, P.U + (row0 * INC + COL_G + 64 * h) + loffU);
#pragma unroll 1
        for (int m = 0; m < NT; ++m) {
            const int mn = (m + 1 < NT) ? m + 1 : m;
            const bf16* nrow = P.U + ((row0 + 16 * mn) * INC + 64 * h);
            ld2(xn, nrow + COL_XR + loffU);
            if (PASS == 1) ld2(gnx, nrow + COL_G + loffU);
            asm volatile("" ::: "memory");
            lru_tile<PASS>(lds, xc, xp, gcur, WA, WX, hc, ac, P.Y + ((row0 + 16 * m) * MIXW + CW + 64 * h) + loffY, ch0, fr, fq, 16 * m + fr, h);
            xp[0] = xc[0]; xp[1] = xc[1]; xc[0] = xn[0]; xc[1] = xn[1]; gcur[0] = gnx[0]; gcur[1] = gnx[1];
        }
        if (PASS == 0) {
            if (fr == 15) { const size_t o = ((size_t)(b * NCHUNK + c)) * LW + ch0;
#pragma unroll
                for (int q = 0; q < 4; ++q) { *(f32x4*)(P.SUMA + o + 4 * q) = (f32x4){ac[4 * q], ac[4 * q + 1], ac[4 * q + 2], ac[4 * q + 3]};
                                              *(f32x4*)(P.SUMH + o + 4 * q) = (f32x4){hc[4 * q], hc[4 * q + 1], hc[4 * q + 2], hc[4 * q + 3]}; } }
        }
    }
    if (PASS == 1) {
        int lane_c = (int)__lane_id(); asm volatile("" : "+v"(lane_c));
        const int fr = lane_c & 15, fq = lane_c >> 4;
        const int ca0 = 64 * wave + 16 * fq;
        const int loffU = fr * INC + 16 * fq, loffY = fr * MIXW + 16 * fq;
        float pp[16];
        { v4u c_[2], v_[2]; ld2(c_, P.U + (prow0 * INC + COL_GC + 64 * wave) + loffU); ld2(v_, P.U + (prow0 * INC + COL_V + 64 * wave) + loffU);
          const unsigned cwd[8] = {c_[0].x, c_[0].y, c_[0].z, c_[0].w, c_[1].x, c_[1].y, c_[1].z, c_[1].w}; const unsigned vwd[8] = {v_[0].x, v_[0].y, v_[0].z, v_[0].w, v_[1].x, v_[1].y, v_[1].z, v_[1].w};
#pragma unroll
          for (int i = 0; i < 16; ++i) { const float p = (i & 1) ? bf_hi(cwd[i >> 1]) * bf_hi(vwd[i >> 1]) : bf_lo(cwd[i >> 1]) * bf_lo(vwd[i >> 1]); pp[i] = (c == 0) ? 0.f : p; } }
        v4u gc[2], vv[2], gb[2], gcn[2], vvn[2], gbn[2];
        { const bf16* r0 = P.U + (row0 * INC + 64 * wave); ld2(gc, r0 + COL_GC + loffU); ld2(vv, r0 + COL_V + loffU); ld2(gb, r0 + COL_GB + loffU); }
#pragma unroll 1
        for (int m = 0; m < NT; ++m) {
            const int mn = (m + 1 < NT) ? m + 1 : m;
            const bf16* nrow = P.U + ((row0 + 16 * mn) * INC + 64 * wave);
            ld2(gcn, nrow + COL_GC + loffU); ld2(vvn, nrow + COL_V + loffU); ld2(gbn, nrow + COL_GB + loffU);
            asm volatile("" ::: "memory");
            conv_tile(lds, gc, vv, gb, pp, P.Y + ((row0 + 16 * m) * MIXW + 64 * wave) + loffY, ca0, fr, fq, 16 * m + fr, wave);
            gc[0] = gcn[0]; gc[1] = gcn[1]; vv[0] = vvn[0]; vv[1] = vvn[1]; gb[0] = gbn[0]; gb[1] = gbn[1];
        }
        __syncthreads();
        tid = wave * 64 + (int)__lane_id(); asm volatile("" : "+v"(tid));
        if (tid < TCH) {
            const LAS float* sa = (const LAS float*)(lds + L_SSA) + tid * 8; const LAS float* sb = (const LAS float*)(lds + L_SSB) + tid * 16;
            float a = 0.f, bsum = 0.f;
#pragma unroll
            for (int i = 0; i < 8; ++i) a += sa[i];
#pragma unroll
            for (int i = 0; i < 16; ++i) bsum += sb[i];
            const float rA = 1.0f / sqrtf(a * (1.0f / CW) + EPS), rB = 1.0f / sqrtf(bsum * (1.0f / LW) + EPS);
            P.RS[row0 + tid] = (f32x2){rA / rB, rB};
        }
        __syncthreads();
    }
}

__global__ void __launch_bounds__(NWAVES * 64, 2) hybrid_fwd(Args args) {
    extern __shared__ __attribute__((aligned(16))) unsigned char lds_raw[];
    LAS unsigned char* lds = (LAS unsigned char*)lds_raw;
    const int wave = __builtin_amdgcn_readfirstlane(threadIdx.x >> 6); const int lane = (int)__lane_id(); const int tid = wave * 64 + lane;
    const int G = gridDim.x; const int bx = blockIdx.x; const int vcu = (G % 8 == 0) ? (bx % 8) * (G / 8) + bx / 8 : bx;
    unsigned char* ws = args.ws;
    const float* x = args.in[I_X]; float* out = args.out;
    bf16* Win_t = (bf16*)(ws + WS_WIN); bf16* Wout_t = (bf16*)(ws + WS_WOUT); bf16* W1_t = (bf16*)(ws + WS_W1); bf16* W2_t = (bf16*)(ws + WS_W2);
    bf16* WF = (bf16*)(ws + WS_WF); float* NSP = (float*)(ws + WS_NSP); float* SUMA = (float*)(ws + WS_SUMA); float* SUMH = (float*)(ws + WS_SUMH);
    f32x2* RS = (f32x2*)(ws + WS_RS); float* SS1 = (float*)(ws + WS_SS1); float* SS2 = (float*)(ws + WS_SS2);
    bf16* XN = (bf16*)(ws + WS_XN); bf16* U = (bf16*)(ws + WS_U); bf16* Y = (bf16*)(ws + WS_Y); bf16* Z = (bf16*)(ws + WS_Z);
    const int gw = vcu * NWAVES + wave, NGW = G * NWAVES;
    for (int u = tid; u < (LDS_BYTES - RING_BYTES) / 4; u += NWAVES * 64) ((LAS unsigned*)(lds + RING_BYTES))[u] = 0u;
    __syncthreads();
    const XcdBarrier bar = xcd_barrier_post((unsigned*)ws + CW_BAR, (volatile LAS unsigned*)(lds + RING_BYTES) + 8);

    {
        LAS float* scr = (LAS float*)(lds + wave * 16384);
        constexpr int I_IN = (D / 64) * (INC / 32), I_OUT = (MIXW / 64) * (D / 32), I_1 = (D / 64) * (FF / 32), I_2 = (FF / 64) * (D / 32);
        constexpr int NITEMS = I_IN + I_OUT + I_1 + I_2;
        for (int it = gw; it < NITEMS; it += NGW) {
            int r = it;
            if (r < I_IN) { p0_transpose_item(args.in[I_WIN], D, INC, Win_t, scr, r, lane, nullptr, nullptr, 0); continue; } r -= I_IN;
            if (r < I_OUT) { p0_transpose_item(args.in[I_WOUT], MIXW, D, Wout_t, scr, r, lane, args.in[I_GCONV], args.in[I_GRNN], CW); continue; } r -= I_OUT;
            if (r < I_1) { p0_transpose_item(args.in[I_W1], D, FF, W1_t, scr, r, lane, args.in[I_GMLP], args.in[I_GMLP], D); continue; } r -= I_1;
            p0_transpose_item(args.in[I_W2], FF, D, W2_t, scr, r, lane, nullptr, nullptr, 0);
        }
        for (int idx = vcu * (NWAVES * 64) + tid; idx < NH * 2 * 4 * 2 * 64; idx += G * NWAVES * 64) {
            const int ln = idx & 63, s = (idx >> 6) & 1, n = (idx >> 7) & 3, gate = (idx >> 9) & 1, h = idx >> 10;
            const int r = ln & 15, fqp = ln >> 4, oc = 16 * (r >> 2) + 4 * n + (r & 3);
            const float* w = (gate ? args.in[I_WX] : args.in[I_WA]) + (size_t)h * 4096 + oc;
            float v[8];
#pragma unroll
            for (int j = 0; j < 8; ++j) v[j] = w[(16 * fqp + 8 * s + j) * 64];
            v4u o; o.x = pk2(v[0], v[1]); o.y = pk2(v[2], v[3]); o.z = pk2(v[4], v[5]); o.w = pk2(v[6], v[7]);
            *(v4u*)(WF + (size_t)idx * 8) = o;
        }
        for (int idx = vcu * (NWAVES * 64) + tid; idx < LW; idx += G * NWAVES * 64) NSP[idx] = -8.0f * log1pf(expf(-args.in[I_LAM][idx]));
        { const float* gm = args.in[I_GMIX]; f32x4 gv[4];
#pragma unroll
          for (int j = 0; j < 4; ++j) gv[j] = *((const f32x4*)gm + lane + 64 * j);
          for (int m = gw; m < M; m += NGW) {
            const f32x4* xr = (const f32x4*)(x + (size_t)m * D) + lane; f32x4 v[4]; float s2 = 0.f;
#pragma unroll
            for (int j = 0; j < 4; ++j) { v[j] = xr[64 * j]; s2 += (v[j].x * v[j].x + v[j].y * v[j].y) + (v[j].z * v[j].z + v[j].w * v[j].w); }
            const float rstd = 1.0f / sqrtf(wave_sum(s2) * (1.0f / D) + EPS);
            unsigned long long* o8 = (unsigned long long*)(XN + (size_t)m * D) + lane;
#pragma unroll
            for (int j = 0; j < 4; ++j) o8[64 * j] = (unsigned long long)pk2(v[j].x * rstd * gv[j].x, v[j].y * rstd * gv[j].y) | ((unsigned long long)pk2(v[j].z * rstd * gv[j].z, v[j].w * rstd * gv[j].w) << 32);
          } }
    }
    xcd_barrier(bar);

    {
        pg8::Gemm g{XN, Win_t, M, INC, D}; pg8::StaticOrder S; S.init(M, INC, G, bx);
        pg8::EpiStoreBf16 E{U, INC};
        pg8::gemm_phase<pg8::EpiStoreBf16, pg8::StaticOrder, true, true>(lds, g, S, E);
    }
    xcd_barrier(bar);

    {
        int tid2 = wave * 64 + (int)__lane_id(); asm volatile("" : "+v"(tid2));
        for (int i = tid2; i < 4 * LW; i += NWAVES * 64) ((LAS float*)(lds + L_RCW))[i] = args.in[I_RCW][i];
        for (int i = tid2; i < LW; i += NWAVES * 64) { ((LAS float*)(lds + L_RCB))[i] = args.in[I_RCB][i]; ((LAS float*)(lds + L_BA))[i] = args.in[I_BA][i]; ((LAS float*)(lds + L_BX))[i] = args.in[I_BX][i]; ((LAS float*)(lds + L_NSP))[i] = NSP[i]; }
        for (int i = tid2; i < 3 * CW; i += NWAVES * 64) ((LAS float*)(lds + L_CW))[i] = args.in[I_CONVW][i];
        __syncthreads();
        const MixP P{U, WF, Y, SUMA, SUMH, RS};
#ifndef REP_MIX
#define REP_MIX 1
#endif
        for (int rep = 0; rep < REP_MIX; ++rep) for (int u = vcu; u < BATCH * NCHUNK; u += G) mixer_unit<0>(lds, P, u / NCHUNK, u % NCHUNK, wave, 0, 0);
        xcd_barrier(bar);
        for (int rep = 0; rep < REP_MIX; ++rep) for (int u = vcu; u < BATCH * NCHUNK; u += G) mixer_unit<1>(lds, P, u / NCHUNK, u % NCHUNK, wave, 0, 0);
    }
    xcd_barrier(bar);

    {
        pg8::Gemm g{Y, Wout_t, M, D, MIXW}; pg8::StaticOrder S; S.init(M, D, G, bx);
        pg8::EpiResid E{x, out, XN, (const pg8::f32x2*)RS, SS1, D};
        pg8::gemm_phase<pg8::EpiResid, pg8::StaticOrder, true, true, CW / 64>(lds, g, S, E);
    }
    xcd_barrier(bar);

    {
        pg8::Gemm g{XN, W1_t, M, FF, D}; pg8::StaticOrder S; S.init(M, FF, G, bx);
        pg8::EpiRelu2 E{Z, FF, SS1, 1.0f / D, EPS};
        pg8::gemm_phase<pg8::EpiRelu2, pg8::StaticOrder, true, true>(lds, g, S, E);
    }
    xcd_barrier(bar);

    {
        pg8::Gemm g{Z, W2_t, M, D, FF}; pg8::StaticOrder S; S.init(M, D, G, bx);
        pg8::EpiResid E{out, out, nullptr, nullptr, SS2, D};
        pg8::gemm_phase<pg8::EpiResid, pg8::StaticOrder, true, true>(lds, g, S, E);
    }
    xcd_barrier(bar);

    {
        int lane6 = (int)__lane_id(); asm volatile("" : "+v"(lane6));
        const float* gf = args.in[I_GFIN]; f32x4 gv[4];
#pragma unroll
        for (int j = 0; j < 4; ++j) gv[j] = *((const f32x4*)gf + lane6 + 64 * j);
        for (int m = gw; m < M; m += NGW) {
            const float p = (lane6 < 16) ? SS2[(size_t)m * 16 + lane6] : 0.f;
            const float rstd = 1.0f / sqrtf(wave_sum(p) * (1.0f / D) + EPS);
            f32x4* xr = (f32x4*)(out + (size_t)m * D) + lane6;
#pragma unroll
            for (int j = 0; j < 4; ++j) { const f32x4 v = xr[64 * j]; xr[64 * j] = v * rstd * gv[j]; }
        }
    }
}

extern "C" void kernel_launch(void* const* d_in, const int* in_sizes, int n_in, void* d_out, int out_size, void* d_ws, size_t ws_size, hipStream_t stream) {
    static int grid = 0;
    if (grid == 0) {
        if (n_in != 18 || in_sizes[0] != M * D || out_size != M * D || ws_size < WS_END) { fprintf(stderr, "kernel_launch: unexpected shapes (n_in %d, in0 %d, out %d, ws %zu); nothing launched\n", n_in, n_in > 0 ? in_sizes[0] : -1, out_size, ws_size); grid = -1; return; }
        int dev = 0, cus = 0, per_cu = 0;
        if (hipGetDevice(&dev) != hipSuccess || hipDeviceGetAttribute(&cus, hipDeviceAttributeMultiprocessorCount, dev) != hipSuccess) { grid = -1; return; }
        if (hipFuncSetAttribute((const void*)hybrid_fwd, hipFuncAttributeMaxDynamicSharedMemorySize, LDS_BYTES) != hipSuccess) { fprintf(stderr, "kernel_launch: hipFuncSetAttribute failed\n"); grid = -1; return; }
        if (hipOccupancyMaxActiveBlocksPerMultiprocessor(&per_cu, (const void*)hybrid_fwd, NWAVES * 64, LDS_BYTES) != hipSuccess || per_cu < 1) { fprintf(stderr, "kernel_launch: occupancy query says %d blocks per CU\n", per_cu); (void)hipGetLastError(); grid = -1; return; }
        grid = cus;
    }
    if (grid < 0) return;
    Args a{};
    for (int i = 0; i < 18; ++i) a.in[i] = (const float*)d_in[i];
    a.out = (float*)d_out; a.ws = (unsigned char*)d_ws;
    void* kargs[] = {&a};
    if (hipMemsetAsync(d_ws, 0, CTL_ZERO_BYTES, stream) != hipSuccess) { fprintf(stderr, "kernel_launch: hipMemsetAsync failed\n"); return; }
    const hipError_t e = hipLaunchCooperativeKernel((const void*)hybrid_fwd, dim3(grid), dim3(NWAVES * 64), kargs, LDS_BYTES, stream);
    if (e != hipSuccess) fprintf(stderr, "kernel_launch: cooperative launch failed: %s (grid %d)\n", hipGetErrorString(e), grid);
}
```

```cpp
#include <hip/hip_runtime.h>
#include <cstdio>
#include <cstdint>

__device__ __forceinline__ float xsum16(float v) { return v + __builtin_bit_cast(float, __builtin_amdgcn_ds_swizzle(__builtin_bit_cast(int, v), 0x401F)); }
__device__ __forceinline__ float xsum32(float v) { const unsigned u = __builtin_bit_cast(unsigned, v); const auto r = __builtin_amdgcn_permlane32_swap(u, u, false, false);
    return __builtin_bit_cast(float, (unsigned)r[0]) + __builtin_bit_cast(float, (unsigned)r[1]); }
template <int CTRL> __device__ __forceinline__ float dpp0f(float v) { return __builtin_bit_cast(float, __builtin_amdgcn_update_dpp(0, __builtin_bit_cast(int, v), CTRL, 0xf, 0xf, false)); }
__device__ __forceinline__ float wave_sum_all(float v) {
    v += dpp0f<0xB1>(v); v += dpp0f<0x4E>(v); v += dpp0f<0x141>(v); v += dpp0f<0x140>(v);
    return xsum32(xsum16(v));
}
namespace pg8 {
#define PG8_LAS __attribute__((address_space(3)))
typedef unsigned short bf16_t;
typedef short bf16x8 __attribute__((ext_vector_type(8)));
typedef float f32x4 __attribute__((ext_vector_type(4)));
typedef unsigned u32x4 __attribute__((ext_vector_type(4)));
constexpr int BM = 256, BK = 64, HALF = 128, HTB = HALF * BK * 2  , STAGE_BYTES = 8 * HTB, NXCD = 8, WGM = 8;

__host__ __device__ __forceinline__ int lds_byte(int r, int c) { const int st = (r >> 4) * 2 + (c >> 5), rr = r & 15, cc = c & 31, ob = rr * 64 + cc * 2; return st * 1024 + (ob ^ (((ob >> 9) & 1) << 5)); }
__host__ __device__ __forceinline__ void stage_rc(int b, int& R, int& C) { const int st = b / 1024, sb = b % 1024, swz = sb ^ (((sb >> 9) & 1) << 5); R = (st >> 1) * 16 + swz / 64; C = (st & 1) * 32 + (swz % 64) / 2; }
__host__ __device__ __forceinline__ int perm32(int rho) { const int n = rho >> 4, i = rho & 15; return 8 * (i >> 2) + 4 * n + (i & 3); }

struct Unit { int pm, pn; };
struct Gemm { const bf16_t* A; const bf16_t* Bt; int M, N, K; };

struct StaticOrder {
    int nM, nN, nwg, G, c;
    __host__ __device__ void init(int M, int N, int G_, int c_) { nM = M / BM; nN = N / BM; nwg = nM * nN; G = G_; c = c_; }
    __host__ __device__ bool next(int i, Unit& u) const {
        const long L = (long)i * G + c; if (L >= nwg) return false;
        int wgid = (int)L; { const int q = nwg / NXCD, r = nwg % NXCD, xcd = wgid % NXCD, off = wgid / NXCD; wgid = (xcd < r ? xcd * (q + 1) : r * (q + 1) + (xcd - r) * q) + off; }
        const int nig = WGM * nN, gid = wgid / nig, fm = gid * WGM, gsz = (nM - fm) < WGM ? (nM - fm) : WGM;
        u.pm = fm + ((wgid % nig) % gsz); u.pn = (wgid % nig) / gsz; return true;
    }
    __device__ __forceinline__ void a_ready(const Unit&) const {}
    __device__ __forceinline__ void done(const Unit&) const {}
};

__device__ __forceinline__ unsigned cvt_pk_bf16(float lo, float hi) { unsigned r; asm volatile("v_cvt_pk_bf16_f32 %0, %1, %2" : "=v"(r) : "v"(lo), "v"(hi)); return r; }
typedef float f32x2 __attribute__((ext_vector_type(2)));
typedef unsigned u32x2 __attribute__((ext_vector_type(2)));
struct EpiStoreBf16 {
    static constexpr bool PERM = true, AFTER_DRAIN = false;
    bf16_t* O; int ldc;
    __device__ __forceinline__ void operator()(const f32x4 (&acc)[2][2][4][2], const Unit& u, int wr, int wc, int fr, int fq) const {
        const int row0 = u.pm * BM + wr * 64 + fr; const int col0 = u.pn * BM + wc * 32 + 8 * fq;
#pragma unroll
        for (int ai = 0; ai < 2; ++ai)
#pragma unroll
            for (int m = 0; m < 4; ++m) { bf16_t* rowp = O + (size_t)(row0 + ai * HALF + m * 16) * ldc + col0;
#pragma unroll
                for (int bj = 0; bj < 2; ++bj) { const f32x4 v0 = acc[ai][bj][m][0], v1 = acc[ai][bj][m][1];
                    u32x4 w; w.x = cvt_pk_bf16(v0[0], v0[1]); w.y = cvt_pk_bf16(v0[2], v0[3]); w.z = cvt_pk_bf16(v1[0], v1[1]); w.w = cvt_pk_bf16(v1[2], v1[3]);
                    *(u32x4*)(rowp + bj * HALF) = w; } }
    }
};
struct EpiRelu2 {
    static constexpr bool PERM = true, AFTER_DRAIN = false;
    bf16_t* O; int ldc; const float* ss; float inv_n, eps;
    __device__ __forceinline__ void operator()(const f32x4 (&acc)[2][2][4][2], const Unit& u, int wr, int wc, int fr, int fq) const {
        const int row0 = u.pm * BM + wr * 64 + fr; const int col0 = u.pn * BM + wc * 32 + 8 * fq;
#pragma unroll
        for (int ai = 0; ai < 2; ++ai)
#pragma unroll
            for (int m = 0; m < 4; ++m) { const int row = row0 + ai * HALF + m * 16;
                const f32x4 p = *(const f32x4*)(ss + (size_t)row * 16 + 4 * fq);
                float s = (p[0] + p[1]) + (p[2] + p[3]); s = xsum32(xsum16(s));
                const float rstd = 1.0f / sqrtf(s * inv_n + eps);
                bf16_t* rowp = O + (size_t)row * ldc + col0;
#pragma unroll
                for (int bj = 0; bj < 2; ++bj) { f32x4 v0 = acc[ai][bj][m][0] * rstd, v1 = acc[ai][bj][m][1] * rstd;
#pragma unroll
                    for (int e = 0; e < 4; ++e) { const float a0 = fmaxf(v0[e], 0.f), a1 = fmaxf(v1[e], 0.f); v0[e] = a0 * a0; v1[e] = a1 * a1; }
                    u32x4 w; w.x = cvt_pk_bf16(v0[0], v0[1]); w.y = cvt_pk_bf16(v0[2], v0[3]); w.z = cvt_pk_bf16(v1[0], v1[1]); w.w = cvt_pk_bf16(v1[2], v1[3]);
                    *(u32x4*)(rowp + bj * HALF) = w; } }
    }
};
struct EpiMix {
    static constexpr bool PERM = true, AFTER_DRAIN = false;
    const float* base; bf16_t* xb; const f32x2* rs; float* ss; int ldc;
    __device__ __forceinline__ void rescale(f32x4 (&acc)[2][2][4][2], const Unit& u, int wr, int fr) const {
#pragma unroll
        for (int ai = 0; ai < 2; ++ai)
#pragma unroll
            for (int m = 0; m < 4; ++m) { const int row = u.pm * BM + ai * HALF + wr * 64 + m * 16 + fr; const float f = rs[row].x;
#pragma unroll
                for (int bj = 0; bj < 2; ++bj)
#pragma unroll
                    for (int n = 0; n < 2; ++n) acc[ai][bj][m][n] = acc[ai][bj][m][n] * f; }
    }
    __device__ __forceinline__ void operator()(const f32x4 (&acc)[2][2][4][2], const Unit& u, int wr, int wc, int fr, int fq) const {
        const int col0 = u.pn * BM + wc * 32 + 8 * fq;
#pragma unroll
        for (int ai = 0; ai < 2; ++ai)
#pragma unroll
            for (int m = 0; m < 4; ++m) { const int row = u.pm * BM + ai * HALF + wr * 64 + m * 16 + fr; const size_t off = (size_t)row * ldc + col0;
                const float sc = rs[row].y; float q = 0.f;
#pragma unroll
                for (int bj = 0; bj < 2; ++bj) { const f32x4 b0 = *(const f32x4*)(base + off + bj * HALF), b1 = *(const f32x4*)(base + off + bj * HALF + 4);
                    const f32x4 o0 = b0 + acc[ai][bj][m][0] * sc, o1 = b1 + acc[ai][bj][m][1] * sc;
                    q += ((o0[0] * o0[0] + o0[1] * o0[1]) + (o0[2] * o0[2] + o0[3] * o0[3])) + ((o1[0] * o1[0] + o1[1] * o1[1]) + (o1[2] * o1[2] + o1[3] * o1[3]));
                    u32x4 w; w.x = cvt_pk_bf16(o0[0], o0[1]); w.y = cvt_pk_bf16(o0[2], o0[3]); w.z = cvt_pk_bf16(o1[0], o1[1]); w.w = cvt_pk_bf16(o1[2], o1[3]);
                    *(u32x4*)(xb + off + bj * HALF) = w; }
                q = xsum32(xsum16(q));
                if (fq == 0) ss[(size_t)row * 16 + 4 * u.pn + wc] = q;
                if (m & 1) asm volatile("" ::: "memory"); }
    }
};
struct EpiMlp {
    static constexpr bool PERM = true, AFTER_DRAIN = false;
    bf16_t* xb; float* ss; int ldc;
    __device__ __forceinline__ void operator()(const f32x4 (&acc)[2][2][4][2], const Unit& u, int wr, int wc, int fr, int fq) const {
        const int col0 = u.pn * BM + wc * 32 + 8 * fq;
#pragma unroll
        for (int ai = 0; ai < 2; ++ai)
#pragma unroll
            for (int m = 0; m < 4; ++m) { const int row = u.pm * BM + ai * HALF + wr * 64 + m * 16 + fr; const size_t off = (size_t)row * ldc + col0; float q = 0.f;
#pragma unroll
                for (int bj = 0; bj < 2; ++bj) { const u32x4 b = *(const u32x4*)(xb + off + bj * HALF);
                    const f32x4 b0 = (f32x4){__builtin_bit_cast(float, b.x << 16), __builtin_bit_cast(float, b.x & 0xffff0000u), __builtin_bit_cast(float, b.y << 16), __builtin_bit_cast(float, b.y & 0xffff0000u)};
                    const f32x4 b1 = (f32x4){__builtin_bit_cast(float, b.z << 16), __builtin_bit_cast(float, b.z & 0xffff0000u), __builtin_bit_cast(float, b.w << 16), __builtin_bit_cast(float, b.w & 0xffff0000u)};
                    const f32x4 o0 = b0 + acc[ai][bj][m][0], o1 = b1 + acc[ai][bj][m][1];
                    q += ((o0[0] * o0[0] + o0[1] * o0[1]) + (o0[2] * o0[2] + o0[3] * o0[3])) + ((o1[0] * o1[0] + o1[1] * o1[1]) + (o1[2] * o1[2] + o1[3] * o1[3]));
                    u32x4 w; w.x = cvt_pk_bf16(o0[0], o0[1]); w.y = cvt_pk_bf16(o0[2], o0[3]); w.z = cvt_pk_bf16(o1[0], o1[1]); w.w = cvt_pk_bf16(o1[2], o1[3]);
                    *(u32x4*)(xb + off + bj * HALF) = w; }
                q = xsum32(xsum16(q));
                if (fq == 0) ss[(size_t)row * 16 + 4 * u.pn + wc] = q;
                if (m & 1) asm volatile("" ::: "memory"); }
    }
};
template <class Epi, class Sched, bool ALIGN_EPI = false, bool SP2 = false, int RST = -1>
__device__ __forceinline__ void gemm_phase(PG8_LAS unsigned char* lds, const Gemm g, const Sched& S, const Epi& E) {
    int tid_ = __builtin_amdgcn_readfirstlane(threadIdx.x >> 6) * 64 + (int)__lane_id(); asm volatile("" : "+v"(tid_));
    const int tid = tid_, wid = __builtin_amdgcn_readfirstlane(tid >> 6), lane = tid & 63, wr = wid >> 2, wc = wid & 3, fr = lane & 15, fq = lane >> 4;
    const int K = g.K, nt = K / BK;
    unsigned voffA[2], voffB[2];
#pragma unroll
    for (int i = 0; i < 2; ++i) { int R, C; stage_rc(tid * 16 + i * 8192, R, C); const int Rb = Epi::PERM ? ((R & ~31) + perm32(R & 31)) : R;
        voffA[i] = (unsigned)(R * K + C) * 2u; voffB[i] = (unsigned)(Rb * K + C) * 2u; }
    const size_t kstep = (size_t)(BK * 2);
    const size_t hstep = (size_t)HALF * K * 2;
    const size_t tstep = 2 * hstep;
    const unsigned ldsw = (unsigned)wid * 1024u;
    const int aoff = lds_byte(wr * 64 + fr, fq * 8), boff = lds_byte(wc * 32 + fr, fq * 8);
#define PG8_SA(b, h) (((b) * 2 + (h)) * HTB)
#define PG8_SB(b, h) ((4 + (b) * 2 + (h)) * HTB)
#define PG8_STAGE(bufoff, gbase, voff) do { _Pragma("unroll") for (int _i = 0; _i < 2; ++_i) \
        __builtin_amdgcn_global_load_lds((const unsigned*)((const char*)(gbase) + (voff)[_i]), (PG8_LAS unsigned*)(lds + (bufoff) + ldsw + _i * 8192), 16, 0, 0); } while (0)
#define PG8_LDA(dst, b, h) do { _Pragma("unroll") for (int m = 0; m < 4; ++m) _Pragma("unroll") for (int k = 0; k < 2; ++k) dst[m][k] = *(const PG8_LAS bf16x8*)(lds + PG8_SA(b, h) + aoff + m * 2048 + k * 1024); } while (0)
#define PG8_LDB(dst, b, h) do { _Pragma("unroll") for (int n = 0; n < 2; ++n) _Pragma("unroll") for (int k = 0; k < 2; ++k) dst[n][k] = *(const PG8_LAS bf16x8*)(lds + PG8_SB(b, h) + boff + n * 2048 + k * 1024); } while (0)
#define PG8_MMA(ai, bj, At, Bt) do { __builtin_amdgcn_s_setprio(1); _Pragma("unroll") for (int m = 0; m < 4; ++m) _Pragma("unroll") for (int n = 0; n < 2; ++n) _Pragma("unroll") for (int k = 0; k < 2; ++k) \
        acc[ai][bj][m][n] = __builtin_amdgcn_mfma_f32_16x16x32_bf16(Bt[n][k], At[m][k], acc[ai][bj][m][n], 0, 0, 0); __builtin_amdgcn_s_setprio(0); } while (0)
#define PG8_WAIT_V(n) asm volatile("s_waitcnt vmcnt(" #n ")" ::: "memory")
#define PG8_WAIT_L(n) asm volatile("s_waitcnt lgkmcnt(" #n ")" ::: "memory")
#define PG8_BAR __builtin_amdgcn_s_barrier()
#define PG8_SCHED __builtin_amdgcn_sched_barrier(0)
    Unit cur, nxt; int ui = 0;
    if (!S.next(0, cur)) return;
    f32x4 acc[2][2][4][2];
#pragma unroll
    for (int a = 0; a < 2; ++a)
#pragma unroll
        for (int b = 0; b < 2; ++b)
#pragma unroll
            for (int m = 0; m < 4; ++m)
#pragma unroll
                for (int n = 0; n < 2; ++n) acc[a][b][m][n] = (f32x4){0.f, 0.f, 0.f, 0.f};
    bf16x8 At[4][2], B0[2][2], B1[2][2];
    const char* cA = (const char*)g.A + (size_t)cur.pm * tstep; const char* cB = (const char*)g.Bt + (size_t)cur.pn * tstep;
    S.a_ready(cur);
    if constexpr (SP2) {
        PG8_STAGE(PG8_SB(0, 0), cB, voffB); PG8_STAGE(PG8_SB(0, 1), cB + hstep, voffB); PG8_STAGE(PG8_SA(0, 0), cA, voffA); PG8_STAGE(PG8_SA(0, 1), cA + hstep, voffA);
        if (wr == 1) PG8_BAR;
        PG8_WAIT_V(2); PG8_BAR;
        PG8_STAGE(PG8_SB(1, 0), cB + kstep, voffB); PG8_STAGE(PG8_SA(1, 0), cA + kstep, voffA); PG8_STAGE(PG8_SB(1, 1), cB + hstep + kstep, voffB);
        PG8_WAIT_V(6); PG8_BAR;
    } else {
        PG8_STAGE(PG8_SB(0, 0), cB, voffB); PG8_STAGE(PG8_SA(0, 0), cA, voffA); PG8_STAGE(PG8_SB(0, 1), cB + hstep, voffB); PG8_STAGE(PG8_SA(0, 1), cA + hstep, voffA);
        if (wr == 1) PG8_BAR;
        PG8_WAIT_V(4); PG8_BAR;
        PG8_STAGE(PG8_SB(1, 0), cB + kstep, voffB); PG8_STAGE(PG8_SA(1, 0), cA + kstep, voffA); PG8_STAGE(PG8_SB(1, 1), cB + hstep + kstep, voffB);
        PG8_WAIT_V(6); PG8_BAR;
    }
    for (;;) {
        const bool has_next = S.next(ui + 1, nxt);
        const char* nA = has_next ? (const char*)g.A + (size_t)nxt.pm * tstep : cA; const char* nB = has_next ? (const char*)g.Bt + (size_t)nxt.pn * tstep : cB;
        for (int t = 0; t < nt; t += 2) {
            const bool last = (t == nt - 2);
            if constexpr (RST >= 0) { if (t == RST) E.rescale(acc, cur, wr, fr); }
            const char* a1 = cA + (size_t)(t + 1) * kstep;
            const char* a2 = last ? nA : cA + (size_t)(t + 2) * kstep; const char* b2 = last ? nB : cB + (size_t)(t + 2) * kstep;
            const char* a3 = a2 + kstep; const char* b3 = b2 + kstep;
            if (last && has_next) S.a_ready(nxt);
            if constexpr (SP2) {
            PG8_LDB(B0, 0, 0); PG8_LDB(B1, 0, 1); PG8_SCHED; PG8_LDA(At, 0, 0); PG8_STAGE(PG8_SA(1, 1), a1 + hstep, voffA);
            PG8_WAIT_V(8); PG8_WAIT_L(0); PG8_BAR; PG8_MMA(0, 0, At, B0); PG8_MMA(0, 1, At, B1); PG8_BAR; PG8_SCHED;
            PG8_LDA(At, 0, 1); PG8_STAGE(PG8_SB(0, 0), b2, voffB); PG8_STAGE(PG8_SB(0, 1), b2 + hstep, voffB); PG8_STAGE(PG8_SA(0, 0), a2, voffA);
            PG8_WAIT_V(8); PG8_WAIT_L(0); PG8_BAR; PG8_MMA(1, 0, At, B0); PG8_MMA(1, 1, At, B1); PG8_BAR; PG8_SCHED;
            PG8_LDB(B0, 1, 0); PG8_LDB(B1, 1, 1); PG8_SCHED; PG8_LDA(At, 1, 0); PG8_STAGE(PG8_SA(0, 1), a2 + hstep, voffA);
            PG8_WAIT_V(8); PG8_WAIT_L(0); PG8_BAR; PG8_MMA(0, 0, At, B0); PG8_MMA(0, 1, At, B1); PG8_BAR; PG8_SCHED;
            PG8_LDA(At, 1, 1); PG8_STAGE(PG8_SB(1, 0), b3, voffB); PG8_STAGE(PG8_SB(1, 1), b3 + hstep, voffB); PG8_STAGE(PG8_SA(1, 0), a3, voffA);
            PG8_WAIT_V(8); PG8_WAIT_L(0); PG8_BAR; PG8_MMA(1, 0, At, B0); PG8_MMA(1, 1, At, B1); PG8_BAR; PG8_SCHED;
            } else {
            PG8_LDB(B0, 0, 0); PG8_SCHED; PG8_LDA(At, 0, 0); PG8_STAGE(PG8_SA(1, 1), a1 + hstep, voffA);
            PG8_WAIT_L(8); PG8_BAR; PG8_WAIT_L(0); PG8_MMA(0, 0, At, B0); PG8_BAR; PG8_SCHED;
            PG8_LDB(B1, 0, 1); PG8_STAGE(PG8_SB(0, 0), b2, voffB);
            PG8_BAR; PG8_WAIT_L(0); PG8_MMA(0, 1, At, B1); PG8_BAR;
            PG8_LDA(At, 0, 1); PG8_STAGE(PG8_SA(0, 0), a2, voffA);
            PG8_BAR; PG8_WAIT_L(0); PG8_MMA(1, 0, At, B0); PG8_BAR; PG8_SCHED;
            PG8_STAGE(PG8_SB(0, 1), b2 + hstep, voffB);
            PG8_WAIT_V(6); PG8_BAR; PG8_MMA(1, 1, At, B1); PG8_BAR;
            PG8_LDB(B0, 1, 0); PG8_SCHED; PG8_LDA(At, 1, 0); PG8_STAGE(PG8_SA(0, 1), a2 + hstep, voffA);
            PG8_WAIT_L(8); PG8_BAR; PG8_WAIT_L(0); PG8_MMA(0, 0, At, B0); PG8_BAR; PG8_SCHED;
            PG8_LDB(B1, 1, 1); PG8_STAGE(PG8_SB(1, 0), b3, voffB);
            PG8_BAR; PG8_WAIT_L(0); PG8_MMA(0, 1, At, B1); PG8_BAR;
            PG8_LDA(At, 1, 1); PG8_STAGE(PG8_SA(1, 0), a3, voffA);
            PG8_BAR; PG8_WAIT_L(0); PG8_MMA(1, 0, At, B0); PG8_BAR; PG8_SCHED;
            PG8_STAGE(PG8_SB(1, 1), b3 + hstep, voffB);
            PG8_WAIT_V(6); PG8_BAR; PG8_MMA(1, 1, At, B1); PG8_BAR;
            }
        }
        if constexpr (ALIGN_EPI) { if (wr == 0) PG8_BAR; }
        if constexpr (!Epi::AFTER_DRAIN) { E(acc, cur, wr, wc, fr, fq); S.done(cur); }
        if (!has_next) break;
#pragma unroll
        for (int a = 0; a < 2; ++a)
#pragma unroll
            for (int b = 0; b < 2; ++b)
#pragma unroll
                for (int m = 0; m < 4; ++m)
#pragma unroll
                    for (int n = 0; n < 2; ++n) acc[a][b][m][n] = (f32x4){0.f, 0.f, 0.f, 0.f};
        cur = nxt; cA = nA; cB = nB; ++ui;
        if constexpr (ALIGN_EPI) { if (wr == 1) PG8_BAR; }
    }
    PG8_WAIT_V(0);
    if constexpr (!ALIGN_EPI) { if (wr == 0) PG8_BAR; }
    PG8_BAR;
    if constexpr (Epi::AFTER_DRAIN) { E.fused(acc, cur, wr, wc, fr, fq, lds, wid, lane); S.done(cur); }
#undef PG8_SA
#undef PG8_SB
#undef PG8_STAGE
#undef PG8_LDA
#undef PG8_LDB
#undef PG8_MMA
#undef PG8_WAIT_V
#undef PG8_WAIT_L
#undef PG8_BAR
#undef PG8_SCHED
}
}
constexpr int NWAVES = 8;
constexpr int BATCH = 8, SEQ = 4096, D = 1024, CW = 512, LW = 1024, MIXW = CW + LW, INC = 3 * CW + 2 * LW, FF = 4096, NH = 16;
constexpr int M = BATCH * SEQ;
constexpr int COL_GB = 0, COL_GC = CW, COL_V = 2 * CW, COL_XR = 3 * CW, COL_G = 3 * CW + LW;
constexpr float EPS = 1e-6f;
constexpr int TCH = 128, NCHUNK = SEQ / TCH;
constexpr size_t MiB = 1u << 20;
constexpr int CW_BAR = 4096; constexpr size_t CTL_ZERO_BYTES = 64 * 1024;
constexpr size_t WS_WIN = 2 * MiB, WS_WOUT = 10 * MiB, WS_W1 = 14 * MiB, WS_W2 = 22 * MiB;
constexpr size_t WS_WF = 30 * MiB;
constexpr size_t WS_NSP = 30 * MiB + 512 * 1024;
constexpr size_t WS_SUMA = 31 * MiB, WS_SUMH = 32 * MiB;
constexpr size_t WS_RS = 33 * MiB;
constexpr size_t WS_SS1 = 34 * MiB, WS_SS2 = 36 * MiB;
constexpr size_t WS_XN = 40 * MiB;
constexpr size_t WS_U = 104 * MiB;
constexpr size_t WS_Y = 328 * MiB;
constexpr size_t WS_Z = 104 * MiB;
constexpr size_t WS_END = 424 * MiB;
static_assert(WS_XN + (size_t)M * D * 2 <= WS_U && WS_U + (size_t)M * INC * 2 <= WS_Y && WS_Y + (size_t)M * MIXW * 2 <= WS_END && WS_Z + (size_t)M * FF * 2 <= WS_END, "d_ws map");
static_assert(WS_WIN + (size_t)INC * D * 2 <= WS_WOUT && WS_WOUT + (size_t)D * MIXW * 2 <= WS_W1 && WS_W1 + (size_t)FF * D * 2 <= WS_W2 && WS_W2 + (size_t)FF * D * 2 <= WS_WF, "weights map");
constexpr int RING_BYTES = 131072;
constexpr int LDS_BYTES = 147456;
constexpr int L_RCW = 0, L_RCB = 16384, L_BA = 20480, L_BX = 24576, L_NSP = 28672, L_CW = 32768, L_SSA = 38912, L_SSB = 43008, L_MIX_END = 51200;

#define LAS __attribute__((address_space(3)))
typedef unsigned short bf16;
typedef unsigned v4u __attribute__((ext_vector_type(4)));
typedef float f32x4 __attribute__((ext_vector_type(4)));
typedef float f32x2 __attribute__((ext_vector_type(2)));
typedef short bf16x8 __attribute__((ext_vector_type(8)));
#define LDS_WAIT() asm volatile("s_waitcnt lgkmcnt(0)" ::: "memory")
__device__ __forceinline__ unsigned pk2(float lo, float hi) { return pg8::cvt_pk_bf16(lo, hi); }
__device__ __forceinline__ float bf_lo(unsigned u) { return __builtin_bit_cast(float, u << 16); }
__device__ __forceinline__ float bf_hi(unsigned u) { return __builtin_bit_cast(float, u & 0xffff0000u); }
__device__ __forceinline__ float wave_sum(float v) { return wave_sum_all(v); }
__device__ __forceinline__ int my_tid() { return __builtin_amdgcn_readfirstlane(threadIdx.x >> 6) * 64 + (int)__lane_id(); }
template <int CTRL> __device__ __forceinline__ float dppf(float oldv, float v) {
    return __builtin_bit_cast(float, __builtin_amdgcn_update_dpp(__builtin_bit_cast(int, oldv), __builtin_bit_cast(int, v), CTRL, 0xf, 0xf, false));
}
__device__ __forceinline__ float sigm(float x) { return __builtin_amdgcn_rcpf(1.0f + __expf(-x)); }

typedef __attribute__((address_space(1))) unsigned gu32;
#define XB_TMO      128
#define XB_XCNT(j)  (256  + 64 * (j))
#define XB_XSUB(j)  (1280 + 64 * (j))
#define XB_XGEN(j)  (2304 + 64 * (j))
#define XB_TOP      3328
#define XB_TOPGEN   3392
#define XCD_BAR_WORDS 3456
#define XB_SPIN_CAP (1u << 18)

__device__ __forceinline__ unsigned xb_ld(unsigned* p)              { return __hip_atomic_load(p, __ATOMIC_RELAXED, __HIP_MEMORY_SCOPE_AGENT); }
__device__ __forceinline__ unsigned xb_add(unsigned* p, unsigned v) { return __hip_atomic_fetch_add(p, v, __ATOMIC_RELAXED, __HIP_MEMORY_SCOPE_AGENT); }
__device__ __forceinline__ unsigned xb_xcc_id() { return (unsigned)__builtin_amdgcn_s_getreg((3 << 11) | 20) & 0xFu; }
#define XB_SPIN(cond, bar) do { unsigned _sp = 0; while (cond) { __builtin_amdgcn_s_sleep(1); \
    if ((++_sp & 255u) == 0u) { if (xb_ld(&(bar)[XB_TMO])) break; if (_sp > XB_SPIN_CAP) { atomicAdd(&(bar)[XB_TMO], 1u); break; } } } } while (0)

struct XcdBarrier {
    unsigned* bar; unsigned x;
    volatile LAS unsigned* st;
};

__device__ __forceinline__ XcdBarrier xcd_barrier_post(unsigned* bar, volatile LAS unsigned* st) {
    XcdBarrier b; b.bar = bar; b.x = xb_xcc_id(); b.st = st;
    if (my_tid() == 0) (void)xb_add(&bar[XB_XCNT(b.x)], 1u);
    return b;
}
__device__ __forceinline__ void xcd_barrier_complete(unsigned* bar, unsigned x, unsigned& nloc, unsigned& nx) {
    const unsigned G = gridDim.x * gridDim.y * gridDim.z;
    unsigned sum, cnt, mine, sp = 0u;
    for (;;) {
        sum = 0u; cnt = 0u; mine = 0u;
#pragma unroll
        for (unsigned j = 0; j < 16; ++j) { const unsigned c = xb_ld(&bar[XB_XCNT(j)]); sum += c; cnt += (c > 0u) ? 1u : 0u; mine = (j == x) ? c : mine; }
        if (sum == G) break;
        __builtin_amdgcn_s_sleep(1);
        if ((++sp & 255u) == 0u) { if (xb_ld(&bar[XB_TMO])) break; if (sp > XB_SPIN_CAP) { atomicAdd(&bar[XB_TMO], 1u); break; } }
    }
    nloc = mine > 0u ? mine : 1u; nx = cnt > 0u ? cnt : 1u;
}

__device__ __forceinline__ void xcd_barrier(const XcdBarrier& b) {
    asm volatile("s_waitcnt vmcnt(0)" ::: "memory");
    __syncthreads();
    if (my_tid() == 0) {
        unsigned* bar = b.bar;
        __builtin_amdgcn_s_waitcnt(0);
        unsigned nloc = b.st[0], nx = b.st[1];
        if (nloc == 0u) { xcd_barrier_complete(bar, b.x, nloc, nx); b.st[0] = nloc; b.st[1] = nx; }
        const unsigned old = xb_add(&bar[XB_XSUB(b.x)], 1u);
        const unsigned gen = old / nloc;
        if (old + 1u == (gen + 1u) * nloc) {
            __builtin_amdgcn_fence(__ATOMIC_RELEASE, "agent");
            asm volatile("s_waitcnt vmcnt(0)" ::: "memory");
            const unsigned og = xb_add(&bar[XB_TOP], 1u);
            const unsigned tg = og / nx;
            if (og + 1u == (tg + 1u) * nx) xb_add(&bar[XB_TOPGEN], 1u);
            else XB_SPIN(xb_ld(&bar[XB_TOPGEN]) == tg, bar);
            __builtin_amdgcn_fence(__ATOMIC_ACQUIRE, "agent");
            xb_add(&bar[XB_XGEN(b.x)], 1u);
            asm volatile("s_waitcnt vmcnt(0)" ::: "memory");
        } else {
            XB_SPIN(xb_ld(&bar[XB_XGEN(b.x)]) == gen, bar);
            __builtin_amdgcn_fence(__ATOMIC_ACQUIRE, "agent");
            asm volatile("s_waitcnt vmcnt(0)" ::: "memory");
        }
    }
    __syncthreads();
}

struct Args { const float* in[18]; float* out; unsigned char* ws; };
enum { I_X = 0, I_GMIX, I_WIN, I_CONVW, I_RCW, I_RCB, I_WA, I_BA, I_WX, I_BX, I_LAM, I_GCONV, I_GRNN, I_WOUT, I_GMLP, I_W1, I_W2, I_GFIN };

__device__ __forceinline__ void p0_transpose_item(const float* W, int K, int N, bf16* WT, LAS float* scr, int item, int lane, const float* g0, const float* g1, int split) {
    const int nblk = N / 32, kb = item / nblk, nb = item % nblk, k0 = 64 * kb, n0 = 32 * nb;
#pragma unroll 8
    for (int i = 0; i < 32; ++i) { const int kk = 2 * i + (lane >> 5); const int k = k0 + kk;
        const float gn = g0 ? (k < split ? g0[k] : g1[k - split]) : 1.0f;
        scr[kk * 33 + (lane & 31)] = W[(size_t)k * N + n0 + (lane & 31)] * gn; }
    LDS_WAIT(); asm volatile("" ::: "memory");
    const int c = lane & 7;
#pragma unroll
    for (int j = 0; j < 4; ++j) { const int n = (lane >> 3) + 8 * j; const LAS float* s = scr + (8 * c) * 33 + n;
        v4u o; o.x = pk2(s[0 * 33], s[1 * 33]); o.y = pk2(s[2 * 33], s[3 * 33]); o.z = pk2(s[4 * 33], s[5 * 33]); o.w = pk2(s[6 * 33], s[7 * 33]);
        *(v4u*)(WT + (size_t)(n0 + n) * K + k0 + 8 * c) = o; }
    LDS_WAIT(); asm volatile("" ::: "memory");
}

struct MixP { const bf16* U; const bf16* WF; bf16* Y; float* SUMA; float* SUMH; f32x2* RS; };

template <int CTRL> __device__ __forceinline__ unsigned dppu(unsigned oldv, unsigned v) { return (unsigned)__builtin_amdgcn_update_dpp((int)oldv, (int)v, CTRL, 0xf, 0xf, false); }
#define SHIFT_U(SH, cur, prev) dppu<0x110 + SH>(dppu<0x120 + SH>(0u, (prev)), (cur))
#define SHIFT_F(SH, cur, prev) dppf<0x110 + SH>(dppf<0x120 + SH>(0.f, (prev)), (cur))
#define DPP_COMBINE(CTRL, Bv, Av) { const float Bs_ = dppf<CTRL>(0.f, Bv), As_ = dppf<CTRL>(1.f, Av); Bv = fmaf(Av, Bs_, Bv); Av *= As_; }
__device__ __forceinline__ void ld2(v4u (&d)[2], const bf16* p) { const v4u* s = (const v4u*)p; d[0] = s[0]; d[1] = s[1]; }

template <int PASS>
__device__ __forceinline__ void lru_tile(LAS unsigned char* lds, const v4u (&xc)[2], const v4u (&xp)[2], const v4u (&gg)[2], const bf16x8 (&WA)[4][2], const bf16x8 (&WX)[4][2], float (&hc)[16], float (&ac)[16],
                                         bf16* yrow, int ch0, int fr, int fq, int tok, int h) {
    const unsigned cw[8] = {xc[0].x, xc[0].y, xc[0].z, xc[0].w, xc[1].x, xc[1].y, xc[1].z, xc[1].w};
    const unsigned pw[8] = {xp[0].x, xp[0].y, xp[0].z, xp[0].w, xp[1].x, xp[1].y, xp[1].z, xp[1].w};
    float xr[16];
#pragma unroll
    for (int q = 0; q < 4; ++q) {
        const f32x4 bs = *(const LAS f32x4*)(lds + L_RCB + (ch0 + 4 * q) * 4);
        const f32x4 w0 = *(const LAS f32x4*)(lds + L_RCW + (0 * LW + ch0 + 4 * q) * 4), w1 = *(const LAS f32x4*)(lds + L_RCW + (1 * LW + ch0 + 4 * q) * 4),
                    w2 = *(const LAS f32x4*)(lds + L_RCW + (2 * LW + ch0 + 4 * q) * 4), w3 = *(const LAS f32x4*)(lds + L_RCW + (3 * LW + ch0 + 4 * q) * 4);
#pragma unroll
        for (int e = 0; e < 2; ++e) { const unsigned c_ = cw[2 * q + e], p_ = pw[2 * q + e];
            const unsigned s1 = SHIFT_U(1, c_, p_), s2 = SHIFT_U(2, c_, p_), s3 = SHIFT_U(3, c_, p_);
            xr[4 * q + 2 * e]     = fmaf(w3[2 * e], bf_lo(c_), fmaf(w2[2 * e], bf_lo(s1), fmaf(w1[2 * e], bf_lo(s2), fmaf(w0[2 * e], bf_lo(s3), bs[2 * e]))));
            xr[4 * q + 2 * e + 1] = fmaf(w3[2 * e + 1], bf_hi(c_), fmaf(w2[2 * e + 1], bf_hi(s1), fmaf(w1[2 * e + 1], bf_hi(s2), fmaf(w0[2 * e + 1], bf_hi(s3), bs[2 * e + 1])))); }
    }
    v4u xb0, xb1;
    xb0.x = pk2(xr[0], xr[1]); xb0.y = pk2(xr[2], xr[3]); xb0.z = pk2(xr[4], xr[5]); xb0.w = pk2(xr[6], xr[7]);
    xb1.x = pk2(xr[8], xr[9]); xb1.y = pk2(xr[10], xr[11]); xb1.z = pk2(xr[12], xr[13]); xb1.w = pk2(xr[14], xr[15]);
    const bf16x8 X0 = __builtin_bit_cast(bf16x8, xb0), X1 = __builtin_bit_cast(bf16x8, xb1);
    const unsigned gwd[8] = {gg[0].x, gg[0].y, gg[0].z, gg[0].w, gg[1].x, gg[1].y, gg[1].z, gg[1].w};
    unsigned yo[8]; float q2 = 0.f;
#pragma unroll
    for (int n = 0; n < 4; ++n) {
        f32x4 aA = (f32x4){0.f, 0.f, 0.f, 0.f}, aX = (f32x4){0.f, 0.f, 0.f, 0.f};
        aA = __builtin_amdgcn_mfma_f32_16x16x32_bf16(WA[n][0], X0, aA, 0, 0, 0); aA = __builtin_amdgcn_mfma_f32_16x16x32_bf16(WA[n][1], X1, aA, 0, 0, 0);
        aX = __builtin_amdgcn_mfma_f32_16x16x32_bf16(WX[n][0], X0, aX, 0, 0, 0); aX = __builtin_amdgcn_mfma_f32_16x16x32_bf16(WX[n][1], X1, aX, 0, 0, 0);
        const f32x4 ba4 = *(const LAS f32x4*)(lds + L_BA + (ch0 + 4 * n) * 4), bx4 = *(const LAS f32x4*)(lds + L_BX + (ch0 + 4 * n) * 4), ns4 = *(const LAS f32x4*)(lds + L_NSP + (ch0 + 4 * n) * 4);
        float yv4[4];
#pragma unroll
        for (int j = 0; j < 4; ++j) {
            const int i = 4 * n + j;
            const float r = sigm(aA[j] + ba4[j]), ig = sigm(aX[j] + bx4[j]);
            const float la = ns4[j] * r; const float av = __expf(la);
            const float mult = __builtin_amdgcn_sqrtf(fmaf(-av, av, 1.0f));
            float bv = mult * ig * xr[i];
            const float hp = dppf<0x121>(0.f, hc[i]);
            bv = (fr == 0) ? fmaf(av, hp, bv) : bv;
            float A = av;
            if (PASS == 0) { const float ap = dppf<0x121>(1.f, ac[i]); A = (fr == 0) ? av * ap : av; }
            DPP_COMBINE(0x111, bv, A) DPP_COMBINE(0x112, bv, A) DPP_COMBINE(0x114, bv, A) DPP_COMBINE(0x118, bv, A)
            hc[i] = bv; if (PASS == 0) ac[i] = A;
            if (PASS == 1) {
                const unsigned gw_ = gwd[i >> 1];
                const float g = (i & 1) ? bf_hi(gw_) : bf_lo(gw_);
                const float u3 = 1.5957691216f * (g + 0.044715f * g * g * g);
                const float yv = bv * (g * sigm(u3));
                yv4[j] = yv; q2 = fmaf(yv, yv, q2);
            }
        }
        if (PASS == 1) { yo[2 * n] = pk2(yv4[0], yv4[1]); yo[2 * n + 1] = pk2(yv4[2], yv4[3]); }
    }
    if (PASS == 1) {
        v4u* dst = (v4u*)yrow; dst[0] = (v4u){yo[0], yo[1], yo[2], yo[3]}; dst[1] = (v4u){yo[4], yo[5], yo[6], yo[7]};
        q2 = xsum32(xsum16(q2));
        if (fq == 0) ((LAS float*)(lds + L_SSB))[tok * 16 + h] = q2;
    }
}

__device__ __forceinline__ void conv_tile(LAS unsigned char* lds, const v4u (&gc)[2], const v4u (&vv)[2], const v4u (&gb)[2], float (&pp)[16], bf16* yrow, int ca0, int fr, int fq, int tok, int wave) {
    const unsigned cwd[8] = {gc[0].x, gc[0].y, gc[0].z, gc[0].w, gc[1].x, gc[1].y, gc[1].z, gc[1].w};
    const unsigned vwd[8] = {vv[0].x, vv[0].y, vv[0].z, vv[0].w, vv[1].x, vv[1].y, vv[1].z, vv[1].w};
    const unsigned bwd[8] = {gb[0].x, gb[0].y, gb[0].z, gb[0].w, gb[1].x, gb[1].y, gb[1].z, gb[1].w};
    unsigned yo[8]; float q2 = 0.f;
#pragma unroll
    for (int q = 0; q < 4; ++q) {
        const f32x4 w0 = *(const LAS f32x4*)(lds + L_CW + (0 * CW + ca0 + 4 * q) * 4), w1 = *(const LAS f32x4*)(lds + L_CW + (1 * CW + ca0 + 4 * q) * 4), w2 = *(const LAS f32x4*)(lds + L_CW + (2 * CW + ca0 + 4 * q) * 4);
        float y4[4];
#pragma unroll
        for (int e = 0; e < 4; ++e) { const int i = 4 * q + e; const unsigned cwd_ = cwd[i >> 1], vwd_ = vwd[i >> 1], bwd_ = bwd[i >> 1];
            const float p = (i & 1) ? bf_hi(cwd_) * bf_hi(vwd_) : bf_lo(cwd_) * bf_lo(vwd_);
            const float s1 = SHIFT_F(1, p, pp[i]), s2 = SHIFT_F(2, p, pp[i]);
            pp[i] = p;
            const float yv = ((i & 1) ? bf_hi(bwd_) : bf_lo(bwd_)) * fmaf(w2[e], p, fmaf(w1[e], s1, w0[e] * s2));
            y4[e] = yv; q2 = fmaf(yv, yv, q2); }
        yo[2 * q] = pk2(y4[0], y4[1]); yo[2 * q + 1] = pk2(y4[2], y4[3]);
    }
    v4u* dst = (v4u*)yrow; dst[0] = (v4u){yo[0], yo[1], yo[2], yo[3]}; dst[1] = (v4u){yo[4], yo[5], yo[6], yo[7]};
    q2 = xsum32(xsum16(q2));
    if (fq == 0) ((LAS float*)(lds + L_SSA))[tok * 8 + wave] = q2;
}

template <int PASS>
__device__ __forceinline__ void mixer_unit(LAS unsigned char* lds, const MixP& P, int b, int c, int wave, int lane, int tid) {
    const size_t rowbase = (size_t)b * SEQ;
    const size_t row0 = rowbase + (size_t)c * TCH;
    const size_t prow0 = c > 0 ? row0 - 16 : row0;
    constexpr int NT = TCH / 16;
#pragma unroll 1
    for (int hl = 0; hl < 2; ++hl) {
        int lane_w = (int)__lane_id(); asm volatile("" : "+v"(lane_w));
        const int fr = lane_w & 15, fq = lane_w >> 4;
        const int h = wave * 2 + hl, ch0 = 64 * h + 16 * fq;
        const int loffU = fr * INC + 16 * fq, loffY = fr * MIXW + 16 * fq;
        float hc[16], ac[16];
#pragma unroll
        for (int i = 0; i < 16; ++i) { hc[i] = 0.f; ac[i] = 1.f; }
        if (PASS == 1) {
            const bool v0 = fr < c, v1 = (16 + fr) < c;
            const size_t o0 = ((size_t)(b * NCHUNK + (v0 ? fr : 0))) * LW + ch0, o1 = ((size_t)(b * NCHUNK + (v1 ? 16 + fr : 0))) * LW + ch0;
#pragma unroll
            for (int q = 0; q < 4; ++q) {
                const f32x4 a0 = *(const f32x4*)(P.SUMA + o0 + 4 * q), h0 = *(const f32x4*)(P.SUMH + o0 + 4 * q), a1 = *(const f32x4*)(P.SUMA + o1 + 4 * q), h1 = *(const f32x4*)(P.SUMH + o1 + 4 * q);
#pragma unroll
                for (int e = 0; e < 4; ++e) {
                    float a = v0 ? a0[e] : 1.f, hh = v0 ? h0[e] : 0.f, a2 = v1 ? a1[e] : 1.f, h2 = v1 ? h1[e] : 0.f;
                    DPP_COMBINE(0x111, hh, a) DPP_COMBINE(0x112, hh, a) DPP_COMBINE(0x114, hh, a) DPP_COMBINE(0x118, hh, a)
                    DPP_COMBINE(0x111, h2, a2) DPP_COMBINE(0x112, h2, a2) DPP_COMBINE(0x114, h2, a2) DPP_COMBINE(0x118, h2, a2)
                    hc[4 * q + e] = fmaf(a2, hh, h2);
                }
            }
            asm volatile("" ::: "memory");
        }
        bf16x8 WA[4][2], WX[4][2];
#pragma unroll
        for (int n = 0; n < 4; ++n)
#pragma unroll
            for (int s = 0; s < 2; ++s) {
                WA[n][s] = *(const bf16x8*)(P.WF + ((size_t)((((h * 2 + 0) * 4 + n) * 2 + s) * 64 + lane_w)) * 8);
                WX[n][s] = *(const bf16x8*)(P.WF + ((size_t)((((h * 2 + 1) * 4 + n) * 2 + s) * 64 + lane_w)) * 8); }
        v4u xp[2], xc[2], xn[2], gcur[2], gnx[2];
        ld2(xp, P.U + (prow0 * INC + COL_XR + 64 * h) + loffU);
        if (c == 0) { xp[0] = (v4u){0u, 0u, 0u, 0u}; xp[1] = xp[0]; }
        ld2(xc, P.U + (row0 * INC + COL_XR + 64 * h) + loffU);
        gcur[0] = (v4u){0u, 0u, 0u, 0u}; gcur[1] = gcur[0]; gnx[0] = gcur[0]; gnx[1] = gcur[0];
        if (PASS == 1) ld2(gcur, P.U + (row0 * INC + COL_G + 64 * h) + loffU);
#pragma unroll 1
        for (int m = 0; m < NT; ++m) {
            const int mn = (m + 1 < NT) ? m + 1 : m;
            const bf16* nrow = P.U + ((row0 + 16 * mn) * INC + 64 * h);
            ld2(xn, nrow + COL_XR + loffU);
            if (PASS == 1) ld2(gnx, nrow + COL_G + loffU);
            asm volatile("" ::: "memory");
            lru_tile<PASS>(lds, xc, xp, gcur, WA, WX, hc, ac, P.Y + ((row0 + 16 * m) * MIXW + CW + 64 * h) + loffY, ch0, fr, fq, 16 * m + fr, h);
            xp[0] = xc[0]; xp[1] = xc[1]; xc[0] = xn[0]; xc[1] = xn[1]; gcur[0] = gnx[0]; gcur[1] = gnx[1];
        }
        if (PASS == 0) {
            if (fr == 15) { const size_t o = ((size_t)(b * NCHUNK + c)) * LW + ch0;
#pragma unroll
                for (int q = 0; q < 4; ++q) { *(f32x4*)(P.SUMA + o + 4 * q) = (f32x4){ac[4 * q], ac[4 * q + 1], ac[4 * q + 2], ac[4 * q + 3]};
                                              *(f32x4*)(P.SUMH + o + 4 * q) = (f32x4){hc[4 * q], hc[4 * q + 1], hc[4 * q + 2], hc[4 * q + 3]}; } }
        }
    }
    if (PASS == 1) {
        int lane_c = (int)__lane_id(); asm volatile("" : "+v"(lane_c));
        const int fr = lane_c & 15, fq = lane_c >> 4;
        const int ca0 = 64 * wave + 16 * fq;
        const int loffU = fr * INC + 16 * fq, loffY = fr * MIXW + 16 * fq;
        float pp[16];
        { v4u c_[2], v_[2]; ld2(c_, P.U + (prow0 * INC + COL_GC + 64 * wave) + loffU); ld2(v_, P.U + (prow0 * INC + COL_V + 64 * wave) + loffU);
          const unsigned cwd[8] = {c_[0].x, c_[0].y, c_[0].z, c_[0].w, c_[1].x, c_[1].y, c_[1].z, c_[1].w}; const unsigned vwd[8] = {v_[0].x, v_[0].y, v_[0].z, v_[0].w, v_[1].x, v_[1].y, v_[1].z, v_[1].w};
#pragma unroll
          for (int i = 0; i < 16; ++i) { const float p = (i & 1) ? bf_hi(cwd[i >> 1]) * bf_hi(vwd[i >> 1]) : bf_lo(cwd[i >> 1]) * bf_lo(vwd[i >> 1]); pp[i] = (c == 0) ? 0.f : p; } }
        v4u gc[2], vv[2], gb[2], gcn[2], vvn[2], gbn[2];
        { const bf16* r0 = P.U + (row0 * INC + 64 * wave); ld2(gc, r0 + COL_GC + loffU); ld2(vv, r0 + COL_V + loffU); ld2(gb, r0 + COL_GB + loffU); }
#pragma unroll 1
        for (int m = 0; m < NT; ++m) {
            const int mn = (m + 1 < NT) ? m + 1 : m;
            const bf16* nrow = P.U + ((row0 + 16 * mn) * INC + 64 * wave);
            ld2(gcn, nrow + COL_GC + loffU); ld2(vvn, nrow + COL_V + loffU); ld2(gbn, nrow + COL_GB + loffU);
            asm volatile("" ::: "memory");
            conv_tile(lds, gc, vv, gb, pp, P.Y + ((row0 + 16 * m) * MIXW + 64 * wave) + loffY, ca0, fr, fq, 16 * m + fr, wave);
            gc[0] = gcn[0]; gc[1] = gcn[1]; vv[0] = vvn[0]; vv[1] = vvn[1]; gb[0] = gbn[0]; gb[1] = gbn[1];
        }
        __syncthreads();
        tid = wave * 64 + (int)__lane_id(); asm volatile("" : "+v"(tid));
        if (tid < TCH) {
            const LAS float* sa = (const LAS float*)(lds + L_SSA) + tid * 8; const LAS float* sb = (const LAS float*)(lds + L_SSB) + tid * 16;
            float a = 0.f, bsum = 0.f;
#pragma unroll
            for (int i = 0; i < 8; ++i) a += sa[i];
#pragma unroll
            for (int i = 0; i < 16; ++i) bsum += sb[i];
            const float rA = 1.0f / sqrtf(a * (1.0f / CW) + EPS), rB = 1.0f / sqrtf(bsum * (1.0f / LW) + EPS);
            P.RS[row0 + tid] = (f32x2){rA / rB, rB};
        }
        __syncthreads();
    }
}

__global__ void __launch_bounds__(NWAVES * 64, 2) hybrid_fwd(Args args) {
    extern __shared__ __attribute__((aligned(16))) unsigned char lds_raw[];
    LAS unsigned char* lds = (LAS unsigned char*)lds_raw;
    const int wave = __builtin_amdgcn_readfirstlane(threadIdx.x >> 6); const int lane = (int)__lane_id(); const int tid = wave * 64 + lane;
    const int G = gridDim.x; const int bx = blockIdx.x; const int vcu = (G % 8 == 0) ? (bx % 8) * (G / 8) + bx / 8 : bx;
    unsigned char* ws = args.ws;
    const float* x = args.in[I_X]; float* out = args.out;
    bf16* Win_t = (bf16*)(ws + WS_WIN); bf16* Wout_t = (bf16*)(ws + WS_WOUT); bf16* W1_t = (bf16*)(ws + WS_W1); bf16* W2_t = (bf16*)(ws + WS_W2);
    bf16* WF = (bf16*)(ws + WS_WF); float* NSP = (float*)(ws + WS_NSP); float* SUMA = (float*)(ws + WS_SUMA); float* SUMH = (float*)(ws + WS_SUMH);
    f32x2* RS = (f32x2*)(ws + WS_RS); float* SS1 = (float*)(ws + WS_SS1); float* SS2 = (float*)(ws + WS_SS2);
    bf16* XN = (bf16*)(ws + WS_XN); bf16* U = (bf16*)(ws + WS_U); bf16* Y = (bf16*)(ws + WS_Y); bf16* Z = (bf16*)(ws + WS_Z);
    const int gw = vcu * NWAVES + wave, NGW = G * NWAVES;
    for (int u = tid; u < (LDS_BYTES - RING_BYTES) / 4; u += NWAVES * 64) ((LAS unsigned*)(lds + RING_BYTES))[u] = 0u;
    __syncthreads();
    const XcdBarrier bar = xcd_barrier_post((unsigned*)ws + CW_BAR, (volatile LAS unsigned*)(lds + RING_BYTES) + 8);

#ifndef REP_P0
#define REP_P0 1
#endif
    for (int rep0 = 0; rep0 < REP_P0; ++rep0) {
        LAS float* scr = (LAS float*)(lds + wave * 16384);
        constexpr int I_IN = (D / 64) * (INC / 32), I_OUT = (MIXW / 64) * (D / 32), I_1 = (D / 64) * (FF / 32), I_2 = (FF / 64) * (D / 32);
        constexpr int NITEMS = I_IN + I_OUT + I_1 + I_2;
        for (int it = gw; it < NITEMS; it += NGW) {
            int r = it;
            if (r < I_IN) { p0_transpose_item(args.in[I_WIN], D, INC, Win_t, scr, r, lane, nullptr, nullptr, 0); continue; } r -= I_IN;
            if (r < I_OUT) { p0_transpose_item(args.in[I_WOUT], MIXW, D, Wout_t, scr, r, lane, args.in[I_GCONV], args.in[I_GRNN], CW); continue; } r -= I_OUT;
            if (r < I_1) { p0_transpose_item(args.in[I_W1], D, FF, W1_t, scr, r, lane, args.in[I_GMLP], args.in[I_GMLP], D); continue; } r -= I_1;
            p0_transpose_item(args.in[I_W2], FF, D, W2_t, scr, r, lane, nullptr, nullptr, 0);
        }
        for (int idx = vcu * (NWAVES * 64) + tid; idx < NH * 2 * 4 * 2 * 64; idx += G * NWAVES * 64) {
            const int ln = idx & 63, s = (idx >> 6) & 1, n = (idx >> 7) & 3, gate = (idx >> 9) & 1, h = idx >> 10;
            const int r = ln & 15, fqp = ln >> 4, oc = 16 * (r >> 2) + 4 * n + (r & 3);
            const float* w = (gate ? args.in[I_WX] : args.in[I_WA]) + (size_t)h * 4096 + oc;
            float v[8];
#pragma unroll
            for (int j = 0; j < 8; ++j) v[j] = w[(16 * fqp + 8 * s + j) * 64];
            v4u o; o.x = pk2(v[0], v[1]); o.y = pk2(v[2], v[3]); o.z = pk2(v[4], v[5]); o.w = pk2(v[6], v[7]);
            *(v4u*)(WF + (size_t)idx * 8) = o;
        }
        for (int idx = vcu * (NWAVES * 64) + tid; idx < LW; idx += G * NWAVES * 64) NSP[idx] = -8.0f * log1pf(expf(-args.in[I_LAM][idx]));
        { const float* gm = args.in[I_GMIX]; f32x4 gv[4];
#pragma unroll
          for (int j = 0; j < 4; ++j) gv[j] = *((const f32x4*)gm + lane + 64 * j);
          for (int m0 = gw * 4; m0 < M; m0 += NGW * 4) {
            f32x4 v[4][4];
#pragma unroll
            for (int r = 0; r < 4; ++r) { const f32x4* xr = (const f32x4*)(x + (size_t)(m0 + r) * D) + lane;
#pragma unroll
                for (int j = 0; j < 4; ++j) v[r][j] = xr[64 * j]; }
#pragma unroll
            for (int r = 0; r < 4; ++r) { float s2 = 0.f;
#pragma unroll
                for (int j = 0; j < 4; ++j) s2 += (v[r][j].x * v[r][j].x + v[r][j].y * v[r][j].y) + (v[r][j].z * v[r][j].z + v[r][j].w * v[r][j].w);
                const float rstd = 1.0f / sqrtf(wave_sum(s2) * (1.0f / D) + EPS);
                unsigned long long* o8 = (unsigned long long*)(XN + (size_t)(m0 + r) * D) + lane;
#pragma unroll
                for (int j = 0; j < 4; ++j) o8[64 * j] = (unsigned long long)pk2(v[r][j].x * rstd * gv[j].x, v[r][j].y * rstd * gv[j].y) | ((unsigned long long)pk2(v[r][j].z * rstd * gv[j].z, v[r][j].w * rstd * gv[j].w) << 32); }
          } }
    }
    xcd_barrier(bar);

    {
        pg8::Gemm g{XN, Win_t, M, INC, D}; pg8::StaticOrder S; S.init(M, INC, G, bx);
        pg8::EpiStoreBf16 E{U, INC};
        pg8::gemm_phase<pg8::EpiStoreBf16, pg8::StaticOrder, true, true>(lds, g, S, E);
    }
    xcd_barrier(bar);

    {
        int tid2 = wave * 64 + (int)__lane_id(); asm volatile("" : "+v"(tid2));
        for (int i = tid2; i < 4 * LW; i += NWAVES * 64) ((LAS float*)(lds + L_RCW))[i] = args.in[I_RCW][i];
        for (int i = tid2; i < LW; i += NWAVES * 64) { ((LAS float*)(lds + L_RCB))[i] = args.in[I_RCB][i]; ((LAS float*)(lds + L_BA))[i] = args.in[I_BA][i]; ((LAS float*)(lds + L_BX))[i] = args.in[I_BX][i]; ((LAS float*)(lds + L_NSP))[i] = NSP[i]; }
        for (int i = tid2; i < 3 * CW; i += NWAVES * 64) ((LAS float*)(lds + L_CW))[i] = args.in[I_CONVW][i];
        __syncthreads();
        const MixP P{U, WF, Y, SUMA, SUMH, RS};
#ifndef REP_MIX
#define REP_MIX 1
#endif
        for (int rep = 0; rep < REP_MIX; ++rep) for (int u = vcu; u < BATCH * NCHUNK; u += G) mixer_unit<0>(lds, P, u / NCHUNK, u % NCHUNK, wave, 0, 0);
        xcd_barrier(bar);
        for (int rep = 0; rep < REP_MIX; ++rep) for (int u = vcu; u < BATCH * NCHUNK; u += G) mixer_unit<1>(lds, P, u / NCHUNK, u % NCHUNK, wave, 0, 0);
    }
    xcd_barrier(bar);

    {
        pg8::Gemm g{Y, Wout_t, M, D, MIXW}; pg8::StaticOrder S; S.init(M, D, G, bx);
        pg8::EpiMix E{x, XN, (const pg8::f32x2*)RS, SS1, D};
        pg8::gemm_phase<pg8::EpiMix, pg8::StaticOrder, true, true, CW / 64>(lds, g, S, E);
    }
    xcd_barrier(bar);

    {
        pg8::Gemm g{XN, W1_t, M, FF, D}; pg8::StaticOrder S; S.init(M, FF, G, bx);
        pg8::EpiRelu2 E{Z, FF, SS1, 1.0f / D, EPS};
        pg8::gemm_phase<pg8::EpiRelu2, pg8::StaticOrder, true, true>(lds, g, S, E);
    }
    xcd_barrier(bar);

    {
        pg8::Gemm g{Z, W2_t, M, D, FF}; pg8::StaticOrder S; S.init(M, D, G, bx);
        pg8::EpiMlp E{XN, SS2, D};
        pg8::gemm_phase<pg8::EpiMlp, pg8::StaticOrder, true, true>(lds, g, S, E);
    }
    xcd_barrier(bar);

    {
        int lane6 = (int)__lane_id(); asm volatile("" : "+v"(lane6));
        const float* gf = args.in[I_GFIN]; f32x4 gv[4];
#pragma unroll
        for (int j = 0; j < 4; ++j) gv[j] = *((const f32x4*)gf + 4 * lane6 + j);
        for (int m0 = gw * 4; m0 < M; m0 += NGW * 4) {
            v4u xv[4][2]; float p[4];
#pragma unroll
            for (int r = 0; r < 4; ++r) { const v4u* s = (const v4u*)(XN + (size_t)(m0 + r) * D) + 2 * lane6; xv[r][0] = s[0]; xv[r][1] = s[1]; p[r] = (lane6 < 16) ? SS2[(size_t)(m0 + r) * 16 + lane6] : 0.f; }
#pragma unroll
            for (int r = 0; r < 4; ++r) {
                const float rstd = 1.0f / sqrtf(wave_sum(p[r]) * (1.0f / D) + EPS);
                f32x4* o = (f32x4*)(out + (size_t)(m0 + r) * D) + 4 * lane6;
                const unsigned w[8] = {xv[r][0].x, xv[r][0].y, xv[r][0].z, xv[r][0].w, xv[r][1].x, xv[r][1].y, xv[r][1].z, xv[r][1].w};
#pragma unroll
                for (int j = 0; j < 4; ++j) o[j] = (f32x4){bf_lo(w[2 * j]), bf_hi(w[2 * j]), bf_lo(w[2 * j + 1]), bf_hi(w[2 * j + 1])} * rstd * gv[j];
            }
        }
    }
}

extern "C" void kernel_launch(void* const* d_in, const int* in_sizes, int n_in, void* d_out, int out_size, void* d_ws, size_t ws_size, hipStream_t stream) {
    static int grid = 0;
    if (grid == 0) {
        if (n_in != 18 || in_sizes[0] != M * D || out_size != M * D || ws_size < WS_END) { fprintf(stderr, "kernel_launch: unexpected shapes (n_in %d, in0 %d, out %d, ws %zu); nothing launched\n", n_in, n_in > 0 ? in_sizes[0] : -1, out_size, ws_size); grid = -1; return; }
        int dev = 0, cus = 0, per_cu = 0;
        if (hipGetDevice(&dev) != hipSuccess || hipDeviceGetAttribute(&cus, hipDeviceAttributeMultiprocessorCount, dev) != hipSuccess) { grid = -1; return; }
        if (hipFuncSetAttribute((const void*)hybrid_fwd, hipFuncAttributeMaxDynamicSharedMemorySize, LDS_BYTES) != hipSuccess) { fprintf(stderr, "kernel_launch: hipFuncSetAttribute failed\n"); grid = -1; return; }
        if (hipOccupancyMaxActiveBlocksPerMultiprocessor(&per_cu, (const void*)hybrid_fwd, NWAVES * 64, LDS_BYTES) != hipSuccess || per_cu < 1) { fprintf(stderr, "kernel_launch: occupancy query says %d blocks per CU\n", per_cu); (void)hipGetLastError(); grid = -1; return; }
        grid = cus;
    }
    if (grid < 0) return;
    Args a{};
    for (int i = 0; i < 18; ++i) a.in[i] = (const float*)d_in[i];
    a.out = (float*)d_out; a.ws = (unsigned char*)d_ws;
    void* kargs[] = {&a};
    if (hipMemsetAsync(d_ws, 0, CTL_ZERO_BYTES, stream) != hipSuccess) { fprintf(stderr, "kernel_launch: hipMemsetAsync failed\n"); return; }
    const hipError_t e = hipLaunchCooperativeKernel((const void*)hybrid_fwd, dim3(grid), dim3(NWAVES * 64), kargs, LDS_BYTES, stream);
    if (e != hipSuccess) fprintf(stderr, "kernel_launch: cooperative launch failed: %s (grid %d)\n", hipGetErrorString(e), grid);
}
```
